# Optimizing an MI355X kernel written in HIP

```python
import jax, jax.numpy as jnp
from jax import lax
import numpy as np

D_MODEL = 1024
BATCH = 8
SEQ = 4096
DEPTH = 2

GRID_W = 64
CTX_LEN = 256
N_MIXERS = 2
D_FF = 4 * D_MODEL
CONV_W = 3
ML_HEADS = 8
ML_DV = D_MODEL // ML_HEADS
ML_DQK = ML_DV // 2
ML_QK_COLS = 2 * ML_HEADS * ML_DQK
ML_QKV_COLS = ML_QK_COLS + ML_HEADS * ML_DV
ML_PROJ_COLS = ML_QKV_COLS + ML_HEADS * ML_DV
ML_CHUNK = 128
EPS = 1e-6
N_CONV_LAYERS = (DEPTH + N_MIXERS - 1) // N_MIXERS
N_MLSTM_LAYERS = DEPTH // N_MIXERS

kernel_name = 'hybrid_shortconv_mlstm_dit'


def _rmsnorm(x, w):
    x32 = x.astype(jnp.float32)
    y = x32 * lax.rsqrt(jnp.mean(x32 * x32, axis=-1, keepdims=True) + EPS)
    return y.astype(x.dtype) * w


def _modulate(h, shift, scale):
    return h * (1 + scale) + shift


def _dwconv_centred(u, w, axis):
    n = u.shape[axis]
    half = CONV_W // 2
    pad = [(0, 0)] * u.ndim
    pad[axis] = (half, CONV_W - 1 - half)
    up = jnp.pad(u, pad)
    out = w[0] * lax.slice_in_dim(up, 0, n, axis=axis)
    for j in range(1, CONV_W):
        out = out + w[j] * lax.slice_in_dim(up, j, j + n, axis=axis)
    return out


def _short_conv_mixer(h, w_in, conv_w, w_out, rows):
    bsz, t_len, d = h.shape
    b_gate, c_gate, u = jnp.split(h @ w_in, 3, axis=-1)
    u = c_gate * u
    if rows is None:
        y = _dwconv_centred(u, conv_w, axis=1)
    else:
        y = _dwconv_centred(u.reshape(bsz, rows, GRID_W, d), conv_w, axis=2).reshape(bsz, t_len, d)
    return (b_gate * y) @ w_out


def _sqrelu_mlp(h, w1, w2):
    return jnp.square(jax.nn.relu(h @ w1)) @ w2


def _mlstm_inputs(h, w_qkvo, w_if, b_if, with_o):
    bsz, t_len, _ = h.shape
    p = h @ (w_qkvo if with_o else w_qkvo[:, :ML_QKV_COLS])
    q = p[..., :ML_HEADS * ML_DQK]
    k = p[..., ML_HEADS * ML_DQK:ML_QK_COLS]
    v = p[..., ML_QK_COLS:ML_QKV_COLS]
    o = p[..., ML_QKV_COLS:] if with_o else None

    def heads(a, dh):
        return a.reshape(bsz, t_len, ML_HEADS, dh).transpose(0, 2, 1, 3).astype(jnp.float32)

    q = heads(q, ML_DQK) * (ML_DQK ** -0.5)
    k = heads(k, ML_DQK)
    v = heads(v, ML_DV)
    g = (jnp.einsum('btd,rdg->rbgt', h, w_if) + b_if[:, None, :, None]).astype(jnp.float32)
    ig = g[:, :, :ML_HEADS]
    lf = jax.nn.log_sigmoid(g[:, :, ML_HEADS:])
    return q, k, v, o, ig, lf


def _mlstm_scan(q, k, v, ig, lf, state, with_output):
    bsz, nh, t_len, _ = q.shape
    dv = v.shape[-1]
    nc = t_len // ML_CHUNK

    def chunks(a):
        a = a.reshape(a.shape[:2] + (nc, ML_CHUNK) + a.shape[3:])
        return jnp.moveaxis(a, 2, 0)

    xs = (chunks(q), chunks(k), chunks(v), chunks(ig), chunks(lf))
    tri = jnp.tril(jnp.ones((ML_CHUNK, ML_CHUNK), dtype=bool))

    def body(carry, inp):
        c_mat, n_vec, m = carry
        qc, kc, vc, ic, fc = inp
        b = jnp.cumsum(fc, axis=-1)
        out = None
        if with_output:
            logd = b[..., :, None] - b[..., None, :] + ic[..., None, :]
            logd = jnp.where(tri, logd, -jnp.inf)
            inter = b + m[..., None]
            m_t = jnp.maximum(inter, jnp.max(logd, axis=-1))
            s = jnp.einsum('bhtd,bhsd->bhts', qc, kc) * jnp.exp(logd - m_t[..., None])
            w_inter = jnp.exp(inter - m_t)
            num = jnp.einsum('bhts,bhsv->bhtv', s, vc) + w_inter[..., None] * jnp.einsum('bhtd,bhdv->bhtv', qc, c_mat)
            den = jnp.sum(s, axis=-1) + w_inter * jnp.einsum('bhtd,bhd->bht', qc, n_vec)
            out = num / jnp.maximum(jnp.abs(den), jnp.exp(-m_t))[..., None]
        b_last = b[..., -1]
        dec = b_last[..., None] - b + ic
        m_new = jnp.maximum(b_last + m, jnp.max(dec, axis=-1))
        wk = jnp.exp(dec - m_new[..., None])
        a = jnp.exp(b_last + m - m_new)
        c_new = a[..., None, None] * c_mat + jnp.einsum('bhsd,bhsv->bhdv', kc * wk[..., None], vc)
        n_new = a[..., None] * n_vec + jnp.einsum('bhs,bhsd->bhd', wk, kc)
        return (c_new, n_new, m_new), out

    state, hs = lax.scan(body, state, xs)
    if with_output:
        hs = jnp.moveaxis(hs, 0, 2).reshape(bsz, nh, t_len, dv)
    return hs, state


def _mlstm_readout(h, o, norm_w, w_out):
    bsz, nh, t_len, dv = h.shape
    h = h.transpose(0, 2, 1, 3)
    h = h * lax.rsqrt(jnp.mean(h * h, axis=-1, keepdims=True) + EPS)
    h = h.reshape(bsz, t_len, nh * dv).astype(o.dtype) * norm_w
    return (jax.nn.sigmoid(o) * h) @ w_out


def _mlstm_mixer(hx, hc, w_qkvo, w_if, b_if, norm_w, w_out, ctx_out):
    qx, kx, vx, ox, igx, lfx = _mlstm_inputs(hx, w_qkvo, w_if, b_if, True)
    qc, kc, vc, oc, igc, lfc = _mlstm_inputs(hc, w_qkvo, w_if, b_if, ctx_out)
    bsz = hx.shape[0]
    zero = (jnp.zeros((bsz, ML_HEADS, ML_DQK, ML_DV), jnp.float32),
            jnp.zeros((bsz, ML_HEADS, ML_DQK), jnp.float32),
            jnp.zeros((bsz, ML_HEADS), jnp.float32))
    hx_sum = 0.0
    hc_sum = 0.0
    for r in range(2):
        if r == 0:
            flip = lambda a: a
        else:
            flip = lambda a: jnp.flip(a, axis=2)
        hc_r, st = _mlstm_scan(flip(qc), flip(kc), flip(vc), flip(igc[r]), flip(lfc[r]), zero, ctx_out)
        hx_r, _ = _mlstm_scan(flip(qx), flip(kx), flip(vx), flip(igx[r]), flip(lfx[r]), st, True)
        hx_sum = hx_sum + flip(hx_r)
        if ctx_out:
            hc_sum = hc_sum + flip(hc_r)
    yx = _mlstm_readout(hx_sum, ox, norm_w, w_out)
    yc = _mlstm_readout(hc_sum, oc, norm_w, w_out) if ctx_out else None
    return yx, yc


def setup_inputs(seed: int = 0) -> dict:
    key = jax.random.key(seed)
    ks = jax.random.split(key, 20)
    f32 = jnp.float32

    def nrm(k, shape, fan_in):
        return jax.random.normal(k, shape, f32) * (fan_in ** -0.5)

    x = jax.random.normal(ks[0], (BATCH, SEQ, D_MODEL), f32)
    c = jax.random.normal(ks[1], (BATCH, D_MODEL), f32)
    ctx = jax.random.normal(ks[2], (BATCH, CTX_LEN, D_MODEL), f32)
    c_ctx = jax.random.normal(ks[3], (D_MODEL,), f32)
    norm_w = 1.0 + 0.02 * jax.random.normal(ks[4], (DEPTH, 4, D_MODEL), f32)
    mod_w = nrm(ks[5], (DEPTH, D_MODEL, 6 * D_MODEL), D_MODEL)
    mod_b = 0.01 * jax.random.normal(ks[6], (DEPTH, 6 * D_MODEL), f32)
    mlp_w1 = nrm(ks[7], (DEPTH, D_MODEL, D_FF), D_MODEL)
    mlp_w2 = nrm(ks[8], (DEPTH, D_FF, D_MODEL), D_FF)
    conv_w_in = nrm(ks[9], (N_CONV_LAYERS, D_MODEL, 3 * D_MODEL), D_MODEL)
    conv_w = nrm(ks[10], (N_CONV_LAYERS, CONV_W, D_MODEL), CONV_W)
    conv_w_out = nrm(ks[11], (N_CONV_LAYERS, D_MODEL, D_MODEL), D_MODEL)
    ml_w_qkvo = nrm(ks[12], (N_MLSTM_LAYERS, D_MODEL, ML_PROJ_COLS), D_MODEL)
    ml_w_if = nrm(ks[13], (N_MLSTM_LAYERS, 2, D_MODEL, 2 * ML_HEADS), D_MODEL)
    ig_b = 0.1 * jax.random.normal(ks[14], (N_MLSTM_LAYERS, 2, ML_HEADS), f32)
    fg_b = jnp.linspace(3.0, 6.0, ML_HEADS, dtype=f32) + 0.1 * jax.random.normal(ks[15], (N_MLSTM_LAYERS, 2, ML_HEADS), f32)
    ml_b_if = jnp.concatenate([ig_b, fg_b], axis=-1)
    ml_norm_w = 1.0 + 0.02 * jax.random.normal(ks[16], (N_MLSTM_LAYERS, ML_HEADS * ML_DV), f32)
    ml_w_out = nrm(ks[17], (N_MLSTM_LAYERS, ML_HEADS * ML_DV, D_MODEL), ML_HEADS * ML_DV)
    return {'x': x, 'c': c, 'ctx': ctx, 'c_ctx': c_ctx, 'norm_w': norm_w, 'mod_w': mod_w, 'mod_b': mod_b,
            'mlp_w1': mlp_w1, 'mlp_w2': mlp_w2, 'conv_w_in': conv_w_in, 'conv_w': conv_w,
            'conv_w_out': conv_w_out, 'ml_w_qkvo': ml_w_qkvo, 'ml_w_if': ml_w_if, 'ml_b_if': ml_b_if,
            'ml_norm_w': ml_norm_w, 'ml_w_out': ml_w_out}


def reference(x, c, ctx, c_ctx, norm_w, mod_w, mod_b, mlp_w1, mlp_w2, conv_w_in, conv_w, conv_w_out,
              ml_w_qkvo, ml_w_if, ml_b_if, ml_norm_w, ml_w_out):
    rows = x.shape[1] // GRID_W
    silu_c = jax.nn.silu(c)[:, None, :]
    silu_cc = jax.nn.silu(c_ctx)
    cx = ctx
    for i in range(DEPTH):
        last = i == DEPTH - 1
        kind = i % N_MIXERS
        j = i // N_MIXERS
        nw = norm_w[i]
        mx = jnp.split(silu_c @ mod_w[i] + mod_b[i], 6, axis=-1)
        hx = _modulate(_rmsnorm(x, nw[0]), mx[0], mx[1])
        need_ctx = (not last) or kind == 1
        if need_ctx:
            mc = jnp.split(silu_cc @ mod_w[i] + mod_b[i], 6, axis=-1)
            hc = _modulate(_rmsnorm(cx, nw[0]), mc[0], mc[1])
        if kind == 0:
            yx = _short_conv_mixer(hx, conv_w_in[j], conv_w[j], conv_w_out[j], rows)
            yc = _short_conv_mixer(hc, conv_w_in[j], conv_w[j], conv_w_out[j], None) if not last else None
        else:
            yx, yc = _mlstm_mixer(hx, hc, ml_w_qkvo[j], ml_w_if[j], ml_b_if[j], ml_norm_w[j], ml_w_out[j],
                                  not last)
        x = x + mx[2] * _rmsnorm(yx, nw[1])
        x = x + mx[5] * _rmsnorm(_sqrelu_mlp(_modulate(_rmsnorm(x, nw[2]), mx[3], mx[4]), mlp_w1[i], mlp_w2[i]), nw[3])
        if not last:
            cx = cx + mc[2] * _rmsnorm(yc, nw[1])
            cx = cx + mc[5] * _rmsnorm(_sqrelu_mlp(_modulate(_rmsnorm(cx, nw[2]), mc[3], mc[4]), mlp_w1[i], mlp_w2[i]), nw[3])
    return x
```

```cpp
#include <hip/hip_runtime.h>
#include <cstdio>
#include <cstdint>
namespace pg8 {
#define PG8_LAS __attribute__((address_space(3)))
typedef unsigned short bf16_t;
typedef short bf16x8 __attribute__((ext_vector_type(8)));
typedef float f32x4 __attribute__((ext_vector_type(4)));
typedef unsigned u32x4 __attribute__((ext_vector_type(4)));
constexpr int BM = 256, BK = 64, HALF = 128, HTB = HALF * BK * 2  , STAGE_BYTES = 8 * HTB, NXCD = 8, WGM = 8;

__host__ __device__ __forceinline__ int lds_byte(int r, int c) { const int st = (r >> 4) * 2 + (c >> 5), rr = r & 15, cc = c & 31, ob = rr * 64 + cc * 2; return st * 1024 + (ob ^ (((ob >> 9) & 1) << 5)); }
__host__ __device__ __forceinline__ void stage_rc(int b, int& R, int& C) { const int st = b / 1024, sb = b % 1024, swz = sb ^ (((sb >> 9) & 1) << 5); R = (st >> 1) * 16 + swz / 64; C = (st & 1) * 32 + (swz % 64) / 2; }
__host__ __device__ __forceinline__ int perm32(int rho) { const int n = rho >> 4, i = rho & 15; return 8 * (i >> 2) + 4 * n + (i & 3); }

struct Unit { int pm, pn, kt0, nkt; };
struct Gemm { const bf16_t* A; const bf16_t* Bt; int M, N, K; };

struct StaticOrder {
    int nM, nN, nwg, G, c, nkt;
    __host__ __device__ void init(int M, int N, int G_, int c_, int K = 1024) { nM = M / BM; nN = N / BM; nwg = nM * nN; G = G_; c = c_; nkt = K / BK; }
    __host__ __device__ bool next(int i, Unit& u) const {
        const long L = (long)i * G + c; if (L >= nwg) return false;
        int wgid = (int)L; { const int q = nwg / NXCD, r = nwg % NXCD, xcd = wgid % NXCD, off = wgid / NXCD; wgid = (xcd < r ? xcd * (q + 1) : r * (q + 1) + (xcd - r) * q) + off; }
        const int nig = WGM * nN, gid = wgid / nig, fm = gid * WGM, gsz = (nM - fm) < WGM ? (nM - fm) : WGM;
        u.pm = fm + ((wgid % nig) % gsz); u.pn = (wgid % nig) / gsz; u.kt0 = 0; u.nkt = nkt; return true;
    }
    __device__ __forceinline__ void a_ready(const Unit&) const {}
    __device__ __forceinline__ void done(const Unit&) const {}
};

__device__ __forceinline__ unsigned cvt_pk_bf16(float lo, float hi) { unsigned r; asm volatile("v_cvt_pk_bf16_f32 %0, %1, %2" : "=v"(r) : "v"(lo), "v"(hi)); return r; }

template <int ACT> struct EpiBf16 {
    static constexpr bool PERM = true, AFTER_DRAIN = false;
    bf16_t* O; int ldc;
    __device__ __forceinline__ void operator()(const f32x4 (&acc)[2][2][4][2], const Unit& u, int wr, int wc, int fr, int fq) const {
        const int row0 = u.pm * BM + wr * 64 + fr, col0 = u.pn * BM + wc * 32 + 8 * fq;
#pragma unroll
        for (int ai = 0; ai < 2; ++ai)
#pragma unroll
            for (int m = 0; m < 4; ++m) { bf16_t* rowp = O + (size_t)(row0 + ai * HALF + m * 16) * ldc + col0;
#pragma unroll
                for (int bj = 0; bj < 2; ++bj) { f32x4 v0 = acc[ai][bj][m][0], v1 = acc[ai][bj][m][1];
                    if (ACT == 2) {
#pragma unroll
                        for (int e = 0; e < 4; ++e) { float a = fmaxf(v0[e], 0.f), b = fmaxf(v1[e], 0.f); v0[e] = a * a; v1[e] = b * b; } }
                    u32x4 w; w.x = cvt_pk_bf16(v0[0], v0[1]); w.y = cvt_pk_bf16(v0[2], v0[3]); w.z = cvt_pk_bf16(v1[0], v1[1]); w.w = cvt_pk_bf16(v1[2], v1[3]);
                    *(u32x4*)(rowp + bj * HALF) = w; } }
    }
};
struct EpiConvIn {
    static constexpr bool PERM = true, AFTER_DRAIN = false;
    bf16_t* O;
    __device__ __forceinline__ void operator()(const f32x4 (&acc)[2][2][4][2], const Unit& u, int wr, int wc, int fr, int fq) const {
        const int row0 = u.pm * BM + wr * 64 + fr;
        if (u.pn < 8) {
            const int col0 = u.pn * 128 + wc * 32 + 8 * fq;
#pragma unroll
            for (int ai = 0; ai < 2; ++ai)
#pragma unroll
                for (int m = 0; m < 4; ++m) { const f32x4 v0 = acc[ai][0][m][0] * acc[ai][1][m][0], v1 = acc[ai][0][m][1] * acc[ai][1][m][1];
                    u32x4 w; w.x = cvt_pk_bf16(v0[0], v0[1]); w.y = cvt_pk_bf16(v0[2], v0[3]); w.z = cvt_pk_bf16(v1[0], v1[1]); w.w = cvt_pk_bf16(v1[2], v1[3]);
                    *(u32x4*)(O + (size_t)(row0 + ai * HALF + m * 16) * 2048 + col0) = w; }
        } else {
            const int col0 = 1024 + (u.pn - 8) * BM + wc * 32 + 8 * fq;
#pragma unroll
            for (int ai = 0; ai < 2; ++ai)
#pragma unroll
                for (int m = 0; m < 4; ++m) { bf16_t* rowp = O + (size_t)(row0 + ai * HALF + m * 16) * 2048 + col0;
#pragma unroll
                    for (int bj = 0; bj < 2; ++bj) { const f32x4 v0 = acc[ai][bj][m][0], v1 = acc[ai][bj][m][1];
                        u32x4 w; w.x = cvt_pk_bf16(v0[0], v0[1]); w.y = cvt_pk_bf16(v0[2], v0[3]); w.z = cvt_pk_bf16(v1[0], v1[1]); w.w = cvt_pk_bf16(v1[2], v1[3]);
                        *(u32x4*)(rowp + bj * HALF) = w; } }
        }
    }
};
struct EpiBf16SS {
    static constexpr bool PERM = true, AFTER_DRAIN = false;
    bf16_t* O; int ldc; float* ss; bf16_t* slab; int skt;
    __device__ __forceinline__ void operator()(const f32x4 (&acc)[2][2][4][2], const Unit& u, int wr, int wc, int fr, int fq) const {
        const int row0 = u.pm * BM + wr * 64 + fr, col0 = u.pn * BM + wc * 32 + 8 * fq;
        const bool piece = slab != nullptr && u.pm >= 128;
        bf16_t* base = piece ? slab + ((long)(u.kt0 / skt) * 2048 - 32768) * 1024 : O;
#pragma unroll
        for (int ai = 0; ai < 2; ++ai)
#pragma unroll
            for (int m = 0; m < 4; ++m) { const int row = row0 + ai * HALF + m * 16; bf16_t* rowp = base + (size_t)row * ldc + col0; float s = 0.f;
#pragma unroll
                for (int bj = 0; bj < 2; ++bj) { const f32x4 v0 = acc[ai][bj][m][0], v1 = acc[ai][bj][m][1];
                    s += (v0[0] * v0[0] + v0[1] * v0[1]) + (v0[2] * v0[2] + v0[3] * v0[3]) + (v1[0] * v1[0] + v1[1] * v1[1]) + (v1[2] * v1[2] + v1[3] * v1[3]);
                    u32x4 w; w.x = cvt_pk_bf16(v0[0], v0[1]); w.y = cvt_pk_bf16(v0[2], v0[3]); w.z = cvt_pk_bf16(v1[0], v1[1]); w.w = cvt_pk_bf16(v1[2], v1[3]);
                    *(u32x4*)(rowp + bj * HALF) = w; }
                if (!piece) { s += __shfl_xor(s, 16); s += __shfl_xor(s, 32);
                    if (fq == 0) (void)__hip_atomic_fetch_add(ss + row, s, __ATOMIC_RELAXED, __HIP_MEMORY_SCOPE_AGENT); } }
    }
};
struct EpiQkvo {
    static constexpr bool PERM = true, AFTER_DRAIN = false;
    bf16_t *Q, *K, *V, *O; float* GP;
    __device__ __forceinline__ void operator()(const f32x4 (&acc)[2][2][4][2], const Unit& u, int wr, int wc, int fr, int fq) const {
        const int row0 = u.pm * BM + wr * 64 + fr;
        if (u.pn == 12) {
            if (wc == 0) {
#pragma unroll
                for (int ai = 0; ai < 2; ++ai)
#pragma unroll
                    for (int m = 0; m < 4; ++m) { float* rowp = GP + (size_t)(row0 + ai * HALF + m * 16) * 32 + 8 * fq;
                        *(f32x4*)(rowp) = acc[ai][0][m][0]; *(f32x4*)(rowp + 4) = acc[ai][0][m][1]; }
            }
            return;
        }
        bf16_t* base; int ldc, colt; float sc = 1.f;
        if (u.pn < 2) { base = Q; ldc = 512; colt = u.pn * BM; sc = 0.125f; }
        else if (u.pn < 4) { base = K; ldc = 512; colt = (u.pn - 2) * BM; }
        else if (u.pn < 8) { base = V; ldc = 1024; colt = (u.pn - 4) * BM; }
        else { base = O; ldc = 1024; colt = (u.pn - 8) * BM; }
        const int col0 = colt + wc * 32 + 8 * fq;
#pragma unroll
        for (int ai = 0; ai < 2; ++ai)
#pragma unroll
            for (int m = 0; m < 4; ++m) { bf16_t* rowp = base + (size_t)(row0 + ai * HALF + m * 16) * ldc + col0;
#pragma unroll
                for (int bj = 0; bj < 2; ++bj) { const f32x4 v0 = acc[ai][bj][m][0] * sc, v1 = acc[ai][bj][m][1] * sc;
                    u32x4 w; w.x = cvt_pk_bf16(v0[0], v0[1]); w.y = cvt_pk_bf16(v0[2], v0[3]); w.z = cvt_pk_bf16(v1[0], v1[1]); w.w = cvt_pk_bf16(v1[2], v1[3]);
                    *(u32x4*)(rowp + bj * HALF) = w; } }
    }
};
struct QkvoOrder {
    StaticOrder so;
    __host__ __device__ void init(int G_, int c_) { so.init(32768, 3328, G_, c_); }
    __host__ __device__ bool next(int i, Unit& u) const {
        const long L = (long)i * so.G + so.c;
        if (L < so.nwg) return so.next(i, u);
        const int e = (int)(L - so.nwg); if (e >= 56) return false;
        const int ti = e >> 3; u.pm = 128 + (e & 7); u.pn = ti < 6 ? 2 + ti : 12; u.kt0 = 0; u.nkt = so.nkt; return true;
    }
    __device__ __forceinline__ void a_ready(const Unit&) const {}
    __device__ __forceinline__ void done(const Unit&) const {}
};

struct SplitOrder {
    StaticOrder so; int nks, skt;
    __host__ __device__ void init(int K, int nks_, int G_, int c_) { so.init(32768, 1024, G_, c_, K); nks = nks_; skt = K / BK / nks_; }
    __host__ __device__ bool next(int i, Unit& u) const {
        const long L = (long)i * so.G + so.c;
        if (L < so.nwg) return so.next(i, u);
        const int e = (int)(L - so.nwg); if (e >= 32 * nks) return false;
        u.pm = 128 + (e & 7); u.pn = (e >> 3) & 3; u.kt0 = (e >> 5) * skt; u.nkt = skt; return true;
    }
    __device__ __forceinline__ void a_ready(const Unit&) const {}
    __device__ __forceinline__ void done(const Unit&) const {}
};

template <class Epi, class Sched, bool ALIGN_EPI = false, bool SP2 = false>
__device__ __forceinline__ void gemm_phase(PG8_LAS unsigned char* lds, const Gemm g, const Sched& S, const Epi& E) {
    const int tid = threadIdx.x, wid = __builtin_amdgcn_readfirstlane(tid >> 6), lane = tid & 63, wr = wid >> 2, wc = wid & 3, fr = lane & 15, fq = lane >> 4;
    const int K = g.K;
    unsigned voffA[2], voffB[2];
#pragma unroll
    for (int i = 0; i < 2; ++i) { int R, C; stage_rc(tid * 16 + i * 8192, R, C); const int Rb = Epi::PERM ? ((R & ~31) + perm32(R & 31)) : R;
        voffA[i] = (unsigned)(R * K + C) * 2u; voffB[i] = (unsigned)(Rb * K + C) * 2u; }
    const size_t kstep = (size_t)(BK * 2);
    const size_t hstep = (size_t)HALF * K * 2;
    const size_t tstep = 2 * hstep;
    const unsigned ldsw = (unsigned)wid * 1024u;
    const int aoff = lds_byte(wr * 64 + fr, fq * 8), boff = lds_byte(wc * 32 + fr, fq * 8);
#define PG8_SA(b, h) (((b) * 2 + (h)) * HTB)
#define PG8_SB(b, h) ((4 + (b) * 2 + (h)) * HTB)
#define PG8_STAGE(bufoff, gbase, voff) do { _Pragma("unroll") for (int _i = 0; _i < 2; ++_i) \
        __builtin_amdgcn_global_load_lds((const unsigned*)((const char*)(gbase) + (voff)[_i]), (PG8_LAS unsigned*)(lds + (bufoff) + ldsw + _i * 8192), 16, 0, 0); } while (0)
#define PG8_LDA(dst, b, h) do { _Pragma("unroll") for (int m = 0; m < 4; ++m) _Pragma("unroll") for (int k = 0; k < 2; ++k) dst[m][k] = *(const PG8_LAS bf16x8*)(lds + PG8_SA(b, h) + aoff + m * 2048 + k * 1024); } while (0)
#define PG8_LDB(dst, b, h) do { _Pragma("unroll") for (int n = 0; n < 2; ++n) _Pragma("unroll") for (int k = 0; k < 2; ++k) dst[n][k] = *(const PG8_LAS bf16x8*)(lds + PG8_SB(b, h) + boff + n * 2048 + k * 1024); } while (0)
#define PG8_MMA(ai, bj, At, Bt) do { __builtin_amdgcn_s_setprio(1); _Pragma("unroll") for (int m = 0; m < 4; ++m) _Pragma("unroll") for (int n = 0; n < 2; ++n) _Pragma("unroll") for (int k = 0; k < 2; ++k) \
        acc[ai][bj][m][n] = __builtin_amdgcn_mfma_f32_16x16x32_bf16(Bt[n][k], At[m][k], acc[ai][bj][m][n], 0, 0, 0); __builtin_amdgcn_s_setprio(0); } while (0)
#define PG8_WAIT_V(n) asm volatile("s_waitcnt vmcnt(" #n ")" ::: "memory")
#define PG8_WAIT_L(n) asm volatile("s_waitcnt lgkmcnt(" #n ")" ::: "memory")
#define PG8_BAR __builtin_amdgcn_s_barrier()
#define PG8_SCHED __builtin_amdgcn_sched_barrier(0)
    Unit cur, nxt; int ui = 0;
    if (!S.next(0, cur)) return;
    f32x4 acc[2][2][4][2];
#pragma unroll
    for (int a = 0; a < 2; ++a)
#pragma unroll
        for (int b = 0; b < 2; ++b)
#pragma unroll
            for (int m = 0; m < 4; ++m)
#pragma unroll
                for (int n = 0; n < 2; ++n) acc[a][b][m][n] = (f32x4){0.f, 0.f, 0.f, 0.f};
    bf16x8 At[4][2], B0[2][2], B1[2][2];
    const char* cA = (const char*)g.A + (size_t)cur.pm * tstep + (size_t)cur.kt0 * kstep; const char* cB = (const char*)g.Bt + (size_t)cur.pn * tstep + (size_t)cur.kt0 * kstep;
    S.a_ready(cur);
    if constexpr (SP2) {
        PG8_STAGE(PG8_SB(0, 0), cB, voffB); PG8_STAGE(PG8_SB(0, 1), cB + hstep, voffB); PG8_STAGE(PG8_SA(0, 0), cA, voffA); PG8_STAGE(PG8_SA(0, 1), cA + hstep, voffA);
        if (wr == 1) PG8_BAR;
        PG8_WAIT_V(2); PG8_BAR;
        PG8_STAGE(PG8_SB(1, 0), cB + kstep, voffB); PG8_STAGE(PG8_SA(1, 0), cA + kstep, voffA); PG8_STAGE(PG8_SB(1, 1), cB + hstep + kstep, voffB);
        PG8_WAIT_V(6); PG8_BAR;
    } else {
        PG8_STAGE(PG8_SB(0, 0), cB, voffB); PG8_STAGE(PG8_SA(0, 0), cA, voffA); PG8_STAGE(PG8_SB(0, 1), cB + hstep, voffB); PG8_STAGE(PG8_SA(0, 1), cA + hstep, voffA);
        if (wr == 1) PG8_BAR;
        PG8_WAIT_V(4); PG8_BAR;
        PG8_STAGE(PG8_SB(1, 0), cB + kstep, voffB); PG8_STAGE(PG8_SA(1, 0), cA + kstep, voffA); PG8_STAGE(PG8_SB(1, 1), cB + hstep + kstep, voffB);
        PG8_WAIT_V(6); PG8_BAR;
    }
    for (;;) {
        const bool has_next = S.next(ui + 1, nxt);
        const char* nA = has_next ? (const char*)g.A + (size_t)nxt.pm * tstep + (size_t)nxt.kt0 * kstep : cA; const char* nB = has_next ? (const char*)g.Bt + (size_t)nxt.pn * tstep + (size_t)nxt.kt0 * kstep : cB;
        const int nt = cur.nkt;
        for (int t = 0; t < nt; t += 2) {
            const bool last = (t == nt - 2);
            const char* a1 = cA + (size_t)(t + 1) * kstep;
            const char* a2 = last ? nA : cA + (size_t)(t + 2) * kstep; const char* b2 = last ? nB : cB + (size_t)(t + 2) * kstep;
            const char* a3 = a2 + kstep; const char* b3 = b2 + kstep;
            if (last && has_next) S.a_ready(nxt);
            if constexpr (SP2) {
            PG8_LDB(B0, 0, 0); PG8_LDB(B1, 0, 1); PG8_SCHED; PG8_LDA(At, 0, 0); PG8_STAGE(PG8_SA(1, 1), a1 + hstep, voffA);
            PG8_WAIT_V(8); PG8_WAIT_L(0); PG8_BAR; PG8_MMA(0, 0, At, B0); PG8_MMA(0, 1, At, B1); PG8_BAR; PG8_SCHED;
            PG8_LDA(At, 0, 1); PG8_STAGE(PG8_SB(0, 0), b2, voffB); PG8_STAGE(PG8_SB(0, 1), b2 + hstep, voffB); PG8_STAGE(PG8_SA(0, 0), a2, voffA);
            PG8_WAIT_V(8); PG8_WAIT_L(0); PG8_BAR; PG8_MMA(1, 0, At, B0); PG8_MMA(1, 1, At, B1); PG8_BAR; PG8_SCHED;
            PG8_LDB(B0, 1, 0); PG8_LDB(B1, 1, 1); PG8_SCHED; PG8_LDA(At, 1, 0); PG8_STAGE(PG8_SA(0, 1), a2 + hstep, voffA);
            PG8_WAIT_V(8); PG8_WAIT_L(0); PG8_BAR; PG8_MMA(0, 0, At, B0); PG8_MMA(0, 1, At, B1); PG8_BAR; PG8_SCHED;
            PG8_LDA(At, 1, 1); PG8_STAGE(PG8_SB(1, 0), b3, voffB); PG8_STAGE(PG8_SB(1, 1), b3 + hstep, voffB); PG8_STAGE(PG8_SA(1, 0), a3, voffA);
            PG8_WAIT_V(8); PG8_WAIT_L(0); PG8_BAR; PG8_MMA(1, 0, At, B0); PG8_MMA(1, 1, At, B1); PG8_BAR; PG8_SCHED;
            } else {
            PG8_LDB(B0, 0, 0); PG8_SCHED; PG8_LDA(At, 0, 0); PG8_STAGE(PG8_SA(1, 1), a1 + hstep, voffA);
            PG8_WAIT_L(8); PG8_BAR; PG8_WAIT_L(0); PG8_MMA(0, 0, At, B0); PG8_BAR; PG8_SCHED;
            PG8_LDB(B1, 0, 1); PG8_STAGE(PG8_SB(0, 0), b2, voffB);
            PG8_BAR; PG8_WAIT_L(0); PG8_MMA(0, 1, At, B1); PG8_BAR;
            PG8_LDA(At, 0, 1); PG8_STAGE(PG8_SA(0, 0), a2, voffA);
            PG8_BAR; PG8_WAIT_L(0); PG8_MMA(1, 0, At, B0); PG8_BAR; PG8_SCHED;
            PG8_STAGE(PG8_SB(0, 1), b2 + hstep, voffB);
            PG8_WAIT_V(6); PG8_BAR; PG8_MMA(1, 1, At, B1); PG8_BAR;
            PG8_LDB(B0, 1, 0); PG8_SCHED; PG8_LDA(At, 1, 0); PG8_STAGE(PG8_SA(0, 1), a2 + hstep, voffA);
            PG8_WAIT_L(8); PG8_BAR; PG8_WAIT_L(0); PG8_MMA(0, 0, At, B0); PG8_BAR; PG8_SCHED;
            PG8_LDB(B1, 1, 1); PG8_STAGE(PG8_SB(1, 0), b3, voffB);
            PG8_BAR; PG8_WAIT_L(0); PG8_MMA(0, 1, At, B1); PG8_BAR;
            PG8_LDA(At, 1, 1); PG8_STAGE(PG8_SA(1, 0), a3, voffA);
            PG8_BAR; PG8_WAIT_L(0); PG8_MMA(1, 0, At, B0); PG8_BAR; PG8_SCHED;
            PG8_STAGE(PG8_SB(1, 1), b3 + hstep, voffB);
            PG8_WAIT_V(6); PG8_BAR; PG8_MMA(1, 1, At, B1); PG8_BAR;
            }
        }
        if constexpr (ALIGN_EPI) { if (wr == 0) PG8_BAR; }
        if constexpr (!Epi::AFTER_DRAIN) { E(acc, cur, wr, wc, fr, fq); S.done(cur); }
        if (!has_next) break;
#pragma unroll
        for (int a = 0; a < 2; ++a)
#pragma unroll
            for (int b = 0; b < 2; ++b)
#pragma unroll
                for (int m = 0; m < 4; ++m)
#pragma unroll
                    for (int n = 0; n < 2; ++n) acc[a][b][m][n] = (f32x4){0.f, 0.f, 0.f, 0.f};
        cur = nxt; cA = nA; cB = nB; ++ui;
        if constexpr (ALIGN_EPI) { if (wr == 1) PG8_BAR; }
    }
    PG8_WAIT_V(0);
    if constexpr (!ALIGN_EPI) { if (wr == 0) PG8_BAR; }
    PG8_BAR;
    if constexpr (Epi::AFTER_DRAIN) { E.fused(acc, cur, wr, wc, fr, fq, lds, wid, lane); S.done(cur); }
#undef PG8_SA
#undef PG8_SB
#undef PG8_STAGE
#undef PG8_LDA
#undef PG8_LDB
#undef PG8_MMA
#undef PG8_WAIT_V
#undef PG8_WAIT_L
#undef PG8_BAR
#undef PG8_SCHED
}
}

constexpr int NWAVES = 8;
constexpr int D = 1024, NB = 8, SEQ = 4096, CTXL = 256, FF = 4096, NH = 8, DQK = 64, DV = 128;
constexpr int MX = NB * SEQ, MC = NB * CTXL, MT = MX + MC;
constexpr int NQKVO = 3328;
constexpr float EPS = 1e-6f;
#ifndef N_LAUNCHES
#define N_LAUNCHES 1
#endif
constexpr int N_PHASES = 17;
#ifndef PROBE
#define PROBE 0
#endif

constexpr size_t MiB = 1u << 20;
constexpr size_t WS_CTL = 0, CTL_ZERO_BYTES = 2 * MiB;
constexpr size_t WS_SS = 1 * MiB;
constexpr size_t WS_MOD = 2 * MiB;
constexpr size_t WS_WIN = 4 * MiB, WS_WOUT0 = 10 * MiB, WS_W1A = 12 * MiB, WS_W1B = 20 * MiB, WS_W2A = 28 * MiB, WS_W2B = 36 * MiB, WS_WQKVO = 44 * MiB, WS_WOUT1 = 52 * MiB;
constexpr size_t WS_H = 56 * MiB;
constexpr size_t WS_Y = 124 * MiB;
constexpr size_t WS_RC = 192 * MiB;
constexpr size_t WS_BIG = 200 * MiB;
constexpr size_t WS_Q = WS_BIG, WS_K = WS_Q + 32 * MiB, WS_V = WS_K + 34 * MiB, WS_O = WS_V + 68 * MiB, WS_GP = WS_O + 64 * MiB, WS_HB = WS_GP + 5 * MiB;
constexpr size_t WS_GREC = WS_BIG + 272 * MiB;
constexpr size_t WS_SLAB = WS_GREC;
constexpr size_t WS_END = WS_GREC + 40 * MiB;
static_assert(WS_HB + 64 * MiB <= WS_END, "scan tensors fit");
constexpr int CW_TMO = 0, CW_BAR = 4096;

constexpr int RING_OFF = 0, RING_BYTES = 131072;
constexpr int LDSCTL_OFF = RING_BYTES, MISC_OFF = LDSCTL_OFF + 320;
constexpr int LDS_BYTES = 147456;

#define GAS __attribute__((address_space(1)))
#define LAS __attribute__((address_space(3)))
typedef unsigned short bf16;
typedef unsigned v4u __attribute__((ext_vector_type(4)));
typedef unsigned v2u __attribute__((ext_vector_type(2)));
typedef float f32x4 __attribute__((ext_vector_type(4)));
typedef GAS unsigned gu32;
#define RLX_AGENT __ATOMIC_RELAXED, __HIP_MEMORY_SCOPE_AGENT
#define LDS_WAIT() asm volatile("s_waitcnt lgkmcnt(0)" ::: "memory")
__device__ __forceinline__ unsigned f2bf(float f) { unsigned u = __builtin_bit_cast(unsigned, f); return (u + 0x7fffu + ((u >> 16) & 1u)) >> 16; }
__device__ __forceinline__ unsigned pk2(float lo, float hi) { return f2bf(lo) | (f2bf(hi) << 16); }
__device__ __forceinline__ float bflo(unsigned w) { return __builtin_bit_cast(float, w << 16); }
__device__ __forceinline__ float bfhi(unsigned w) { return __builtin_bit_cast(float, w & 0xffff0000u); }
__device__ __forceinline__ float bf2f(bf16 b) { return __builtin_bit_cast(float, (unsigned)b << 16); }

#define XB_TMO      128
#define XB_XCNT(j)  (256  + 64 * (j))
#define XB_XSUB(j)  (1280 + 64 * (j))
#define XB_XGEN(j)  (2304 + 64 * (j))
#define XB_TOP      3328
#define XB_TOPGEN   3392
#define XCD_BAR_WORDS 3456
#define XB_SPIN_CAP (1u << 18)

__device__ __forceinline__ unsigned xb_ld(unsigned* p)              { return __hip_atomic_load(p, __ATOMIC_RELAXED, __HIP_MEMORY_SCOPE_AGENT); }
__device__ __forceinline__ unsigned xb_add(unsigned* p, unsigned v) { return __hip_atomic_fetch_add(p, v, __ATOMIC_RELAXED, __HIP_MEMORY_SCOPE_AGENT); }
__device__ __forceinline__ unsigned xb_xcc_id() { return (unsigned)__builtin_amdgcn_s_getreg((3 << 11) | 20) & 0xFu; }
#define XB_SPIN(cond, bar) do { unsigned _sp = 0; while (cond) { __builtin_amdgcn_s_sleep(1); \
    if ((++_sp & 255u) == 0u) { if (xb_ld(&(bar)[XB_TMO])) break; if (_sp > XB_SPIN_CAP) { atomicAdd(&(bar)[XB_TMO], 1u); break; } } } } while (0)

struct XcdBarrier {
    unsigned* bar; unsigned x;
    volatile LAS unsigned* st;
};

__device__ __forceinline__ XcdBarrier xcd_barrier_post(unsigned* bar, volatile LAS unsigned* st) {
    XcdBarrier b; b.bar = bar; b.x = xb_xcc_id(); b.st = st;
    if (threadIdx.x == 0) (void)xb_add(&bar[XB_XCNT(b.x)], 1u);
    return b;
}
__device__ __forceinline__ void xcd_barrier_complete(unsigned* bar, unsigned x, unsigned& nloc, unsigned& nx) {
    const unsigned G = gridDim.x * gridDim.y * gridDim.z;
    unsigned sum, cnt, mine, sp = 0u;
    for (;;) {
        sum = 0u; cnt = 0u; mine = 0u;
#pragma unroll
        for (unsigned j = 0; j < 16; ++j) { const unsigned c = xb_ld(&bar[XB_XCNT(j)]); sum += c; cnt += (c > 0u) ? 1u : 0u; mine = (j == x) ? c : mine; }
        if (sum == G) break;
        __builtin_amdgcn_s_sleep(1);
        if ((++sp & 255u) == 0u) { if (xb_ld(&bar[XB_TMO])) break; if (sp > XB_SPIN_CAP) { atomicAdd(&bar[XB_TMO], 1u); break; } }
    }
    nloc = mine > 0u ? mine : 1u; nx = cnt > 0u ? cnt : 1u;
}

__device__ __forceinline__ void xcd_barrier(const XcdBarrier& b) {
    asm volatile("s_waitcnt vmcnt(0)" ::: "memory");
    __syncthreads();
    if (threadIdx.x == 0) {
        unsigned* bar = b.bar;
        __builtin_amdgcn_s_waitcnt(0);
        unsigned nloc = b.st[0], nx = b.st[1];
        if (nloc == 0u) { xcd_barrier_complete(bar, b.x, nloc, nx); b.st[0] = nloc; b.st[1] = nx; }
        const unsigned old = xb_add(&bar[XB_XSUB(b.x)], 1u);
        const unsigned gen = old / nloc;
        if (old + 1u == (gen + 1u) * nloc) {
            __builtin_amdgcn_fence(__ATOMIC_RELEASE, "agent");
            asm volatile("s_waitcnt vmcnt(0)" ::: "memory");
            const unsigned og = xb_add(&bar[XB_TOP], 1u);
            const unsigned tg = og / nx;
            if (og + 1u == (tg + 1u) * nx) xb_add(&bar[XB_TOPGEN], 1u);
            else XB_SPIN(xb_ld(&bar[XB_TOPGEN]) == tg, bar);
            __builtin_amdgcn_fence(__ATOMIC_ACQUIRE, "agent");
            xb_add(&bar[XB_XGEN(b.x)], 1u);
            asm volatile("s_waitcnt vmcnt(0)" ::: "memory");
        } else {
            XB_SPIN(xb_ld(&bar[XB_XGEN(b.x)]) == gen, bar);
            __builtin_amdgcn_fence(__ATOMIC_ACQUIRE, "agent");
            asm volatile("s_waitcnt vmcnt(0)" ::: "memory");
        }
    }
    __syncthreads();
}


struct Frame {
    LAS unsigned char* lds;
    volatile LAS unsigned* MISC;
    gu32* ctl;
    int tid, lane, wave, vcu, G;
    const float *x, *c, *ctx, *cctx, *norm_w, *mod_w, *mod_b, *mlp_w1, *mlp_w2, *conv_w_in, *conv_w, *conv_w_out, *ml_w_qkvo, *ml_w_if, *ml_b_if, *ml_norm_w, *ml_w_out;
    float* out; unsigned char* ws;
};
__device__ __forceinline__ float wave_sum(float v) {
#pragma unroll
    for (int o = 1; o < 64; o <<= 1) v += __shfl_xor(v, o);
    return v;
}
__device__ __forceinline__ int convin_row(int n0) { if (n0 < 1024) return 2048 + n0; const int u = n0 >= 2048, ch = n0 - (u ? 2048 : 1024); return 256 * (ch >> 7) + 128 * u + (ch & 127); }
__device__ __forceinline__ void p0_transpose_item(const float* W, int K, int N, bf16* WT, int row_off, LAS float* scr, int item, int lane, bool convin = false) {
    const int nblk = N / 32, kb = item / nblk, nb = item % nblk, k0 = 64 * kb, n0 = 32 * nb; if (convin) row_off = convin_row(n0) - n0;
#pragma unroll 8
    for (int i = 0; i < 32; ++i) { const int kk = 2 * i + (lane >> 5); scr[kk * 33 + (lane & 31)] = W[(size_t)(k0 + kk) * N + n0 + (lane & 31)]; }
    LDS_WAIT(); asm volatile("" ::: "memory");
    const int c = lane & 7;
#pragma unroll
    for (int j = 0; j < 4; ++j) { const int n = (lane >> 3) + 8 * j; const LAS float* s = scr + (8 * c) * 33 + n;
        v4u o; o.x = pk2(s[0 * 33], s[1 * 33]); o.y = pk2(s[2 * 33], s[3 * 33]); o.z = pk2(s[4 * 33], s[5 * 33]); o.w = pk2(s[6 * 33], s[7 * 33]);
        *(v4u*)(WT + (size_t)(row_off + n0 + n) * K + k0 + 8 * c) = o; }
    LDS_WAIT(); asm volatile("" ::: "memory");
}

__device__ __forceinline__ void p0_prologue(Frame& F) {
    LAS float* sv = (LAS float*)(F.lds);
    LAS float* part = (LAS float*)(F.lds + 9 * 1024 * 4);
    for (int i = F.tid; i < 9 * 1024; i += NWAVES * 64) { const int bb = i >> 10, k = i & 1023; const float cv = bb < 8 ? F.c[bb * 1024 + k] : F.cctx[k]; sv[i] = cv / (1.f + expf(-cv)); }
    __syncthreads();
    float* MOD = (float*)(F.ws + WS_MOD);
    for (int item = F.vcu; item < 192; item += F.G) {
        const int layer = item / 96, jg = item % 96;
        const float* W = F.mod_w + (size_t)layer * 1024 * 6144 + jg * 64 + F.lane;
        const int k0 = F.wave * 128;
        float a0 = 0.f, a1 = 0.f, a2 = 0.f, a3 = 0.f, a4 = 0.f, a5 = 0.f, a6 = 0.f, a7 = 0.f, a8 = 0.f;
#pragma unroll 8
        for (int k = 0; k < 128; ++k) { const float w = W[(size_t)(k0 + k) * 6144]; const LAS float* s = sv + k0 + k;
            a0 += s[0] * w; a1 += s[1024] * w; a2 += s[2048] * w; a3 += s[3072] * w; a4 += s[4096] * w; a5 += s[5120] * w; a6 += s[6144] * w; a7 += s[7168] * w; a8 += s[8192] * w; }
        LAS float* pw = part + F.wave * 9 * 64 + F.lane;
        pw[0] = a0; pw[64] = a1; pw[128] = a2; pw[192] = a3; pw[256] = a4; pw[320] = a5; pw[384] = a6; pw[448] = a7; pw[512] = a8;
        __syncthreads();
        for (int o = F.tid; o < 9 * 64; o += NWAVES * 64) { const int bb = o >> 6, col = o & 63; float s = F.mod_b[layer * 6144 + jg * 64 + col];
#pragma unroll
            for (int w = 0; w < 8; ++w) s += part[(w * 9 + bb) * 64 + col];
            MOD[(size_t)(layer * 9 + bb) * 6144 + jg * 64 + col] = s; }
        __syncthreads();
    }
    __syncthreads();
    LAS float* scr = (LAS float*)(F.lds + RING_OFF + F.wave * 16384);
    const int gw = F.vcu * NWAVES + F.wave, NGW = F.G * NWAVES;
    constexpr int I_IN = 16 * 96, I_O = 16 * 32, I_1 = 16 * 128, I_2 = 64 * 32;
    constexpr int NITEMS = 2 * I_IN + 2 * I_O + 2 * I_1 + 2 * I_2;
    for (int it = gw; it < NITEMS; it += NGW) {
        int r = it;
        if (r < I_IN) { p0_transpose_item(F.conv_w_in, D, 3072, (bf16*)(F.ws + WS_WIN), 0, scr, r, F.lane, true); continue; } r -= I_IN;
        if (r < I_IN) { p0_transpose_item(F.ml_w_qkvo, D, 3072, (bf16*)(F.ws + WS_WQKVO), 0, scr, r, F.lane); continue; } r -= I_IN;
        if (r < I_O) { p0_transpose_item(F.conv_w_out, D, D, (bf16*)(F.ws + WS_WOUT0), 0, scr, r, F.lane); continue; } r -= I_O;
        if (r < I_O) { p0_transpose_item(F.ml_w_out, D, D, (bf16*)(F.ws + WS_WOUT1), 0, scr, r, F.lane); continue; } r -= I_O;
        if (r < I_1) { p0_transpose_item(F.mlp_w1, D, FF, (bf16*)(F.ws + WS_W1A), 0, scr, r, F.lane); continue; } r -= I_1;
        if (r < I_1) { p0_transpose_item(F.mlp_w1 + (size_t)D * FF, D, FF, (bf16*)(F.ws + WS_W1B), 0, scr, r, F.lane); continue; } r -= I_1;
        if (r < I_2) { p0_transpose_item(F.mlp_w2, FF, D, (bf16*)(F.ws + WS_W2A), 0, scr, r, F.lane); continue; } r -= I_2;
        p0_transpose_item(F.mlp_w2 + (size_t)D * FF, FF, D, (bf16*)(F.ws + WS_W2B), 0, scr, r, F.lane);
    }
    bf16* WG = (bf16*)(F.ws + WS_WQKVO) + (size_t)3072 * 1024;
    for (int i = gw * 64 + F.lane; i < 256 * 1024; i += NGW * 64) { const int j = i >> 10, k = i & 1023;
        WG[i] = j < 32 ? (bf16)f2bf(F.ml_w_if[(size_t)(j >> 4) * 1024 * 16 + k * 16 + (j & 15)]) : (bf16)0; }
}

struct Row { f32x4 v[4]; };
__device__ __forceinline__ Row ld_f32(const float* p, int lane) { Row r; const f32x4* q = (const f32x4*)p + lane;
#pragma unroll
    for (int j = 0; j < 4; ++j) r.v[j] = q[64 * j]; return r; }
__device__ __forceinline__ Row ld_bf16(const bf16* p, int lane) { Row r; const v2u* q = (const v2u*)p + lane;
#pragma unroll
    for (int j = 0; j < 4; ++j) { const v2u w = q[64 * j]; r.v[j] = (f32x4){bflo(w.x), bfhi(w.x), bflo(w.y), bfhi(w.y)}; } return r; }
__device__ __forceinline__ void st_f32(float* p, int lane, const Row& r) { f32x4* q = (f32x4*)p + lane;
#pragma unroll
    for (int j = 0; j < 4; ++j) q[64 * j] = r.v[j]; }
__device__ __forceinline__ void st_bf16(bf16* p, int lane, const Row& r) { v2u* q = (v2u*)p + lane;
#pragma unroll
    for (int j = 0; j < 4; ++j) { v2u w; w.x = pk2(r.v[j][0], r.v[j][1]); w.y = pk2(r.v[j][2], r.v[j][3]); q[64 * j] = w; } }
__device__ __forceinline__ float row_ss(const Row& r) { float s = 0.f;
#pragma unroll
    for (int j = 0; j < 4; ++j) s += (r.v[j][0] * r.v[j][0] + r.v[j][1] * r.v[j][1]) + (r.v[j][2] * r.v[j][2] + r.v[j][3] * r.v[j][3]);
    return wave_sum(s); }
struct NormMod { Row wsc, sh; };
__device__ __forceinline__ NormMod mk_normmod(const float* nw, const float* shift, const float* scale, int lane) { NormMod n; const Row w = ld_f32(nw, lane), sc = ld_f32(scale, lane); n.sh = ld_f32(shift, lane);
#pragma unroll
    for (int j = 0; j < 4; ++j) n.wsc.v[j] = w.v[j] * (sc.v[j] + 1.f); return n; }
__device__ __forceinline__ Row norm_mod(const Row& x, const NormMod& n) {
    const float rstd = 1.f / sqrtf(row_ss(x) * (1.f / D) + EPS); Row h;
#pragma unroll
    for (int j = 0; j < 4; ++j) h.v[j] = (x.v[j] * rstd * n.wsc.v[j]) + n.sh.v[j];
    return h; }
__device__ __forceinline__ Row mk_gw(const float* nw, const float* gate, int lane) { const Row w = ld_f32(nw, lane), g = ld_f32(gate, lane); Row o;
#pragma unroll
    for (int j = 0; j < 4; ++j) o.v[j] = w.v[j] * g.v[j]; return o; }
__device__ __forceinline__ Row resid(const Row& x, const Row& y, float ssy, const Row& gw) {
    const float rstd = 1.f / sqrtf(ssy * (1.f / D) + EPS); Row o;
#pragma unroll
    for (int j = 0; j < 4; ++j) o.v[j] = x.v[j] + (y.v[j] * rstd) * gw.v[j];
    return o; }
__device__ __forceinline__ const float* row_in(const Frame& F, int m) { return m < MX ? F.x + (size_t)m * D : F.ctx + (size_t)(m - MX) * D; }
__device__ __forceinline__ float* row_res(const Frame& F, int m) { return m < MX ? F.out + (size_t)m * D : (float*)(F.ws + WS_RC) + (size_t)(m - MX) * D; }
__device__ __forceinline__ bf16* r16a(const Frame& F, int m) { return (bf16*)((unsigned char*)F.out + (size_t)64 * MiB) + (size_t)m * D; }
__device__ __forceinline__ bf16* r16t(const Frame& F, int m) { return m < 28672 ? (bf16*)(F.ws + (size_t)456 * MiB) + (size_t)m * D : (bf16*)(F.ws + WS_RC) + (size_t)(m - 28672) * D; }
__device__ __forceinline__ int batch_of(int m) { return m < MX ? (m >> 12) : 8; }
__device__ __forceinline__ const float* modb(const Frame& F, int layer, int bb, int which) { return (const float*)(F.ws + WS_MOD) + (size_t)(layer * 9 + bb) * 6144 + which * 1024; }
#define ROWBLOCK(nrows) const int gwv_ = F.vcu * NWAVES + F.wave, NGW = F.G * NWAVES, per = ((nrows) + NGW - 1) / NGW, m_lo = gwv_ * per, m_hi = (m_lo + per) < (nrows) ? (m_lo + per) : (nrows)

template <int N> __device__ __forceinline__ void px1_rows(Frame& F, int m, const NormMod& nm, bf16* H) {
    Row x[N];
#pragma unroll
    for (int i = 0; i < N; ++i) x[i] = ld_f32(row_in(F, m + i), F.lane);
#pragma unroll
    for (int i = 0; i < N; ++i) st_bf16(H + (size_t)(m + i) * D, F.lane, norm_mod(x[i], nm));
}
__device__ __forceinline__ void px1(Frame& F) {
    ROWBLOCK(MT); bf16* H = (bf16*)(F.ws + WS_H); int bbc = -1; NormMod nm;
    for (int m = m_lo; m < m_hi;) { const int bb = batch_of(m);
        if (bb != bbc) { nm = mk_normmod(F.norm_w, modb(F, 0, bb, 0), modb(F, 0, bb, 1), F.lane); bbc = bb; }
        if (m + 1 < m_hi && batch_of(m + 1) == bb) { px1_rows<2>(F, m, nm, H); m += 2; } else { px1_rows<1>(F, m, nm, H); m += 1; } }
}
__device__ __forceinline__ void px2(Frame& F) {
    const int gw = F.vcu * NWAVES + F.wave, NGW = F.G * NWAVES; const bf16* P = (const bf16*)(F.ws + WS_BIG); bf16* Z = (bf16*)(F.ws + WS_H);
    const Row w0 = ld_f32(F.conv_w, F.lane), w1 = ld_f32(F.conv_w + 1024, F.lane), w2 = ld_f32(F.conv_w + 2048, F.lane);
    for (int seg = gw; seg < MT / 8; seg += NGW) {
        const int m0 = seg * 8; const int period = m0 < MX ? 64 : 256; const int t0 = (m0 < MX ? m0 : m0 - MX) % period;
        Row up, uc, un;
#pragma unroll
        for (int j = 0; j < 4; ++j) up.v[j] = (f32x4){0.f, 0.f, 0.f, 0.f};
        if (t0 > 0) up = ld_bf16(P + (size_t)(m0 - 1) * 2048, F.lane);
        uc = ld_bf16(P + (size_t)m0 * 2048, F.lane);
#pragma unroll 2
        for (int i = 0; i < 8; ++i) { const int m = m0 + i;
            if (t0 + i + 1 < period) un = ld_bf16(P + (size_t)(m + 1) * 2048, F.lane);
            else {
#pragma unroll
                for (int j = 0; j < 4; ++j) un.v[j] = (f32x4){0.f, 0.f, 0.f, 0.f}; }
            const Row bg = ld_bf16(P + (size_t)m * 2048 + 1024, F.lane); Row z;
#pragma unroll
            for (int j = 0; j < 4; ++j) z.v[j] = bg.v[j] * (w0.v[j] * up.v[j] + w1.v[j] * uc.v[j] + w2.v[j] * un.v[j]);
            st_bf16(Z + (size_t)m * D, F.lane, z); up = uc; uc = un; }
    }
}
template <int N> __device__ __forceinline__ void px3_rows(Frame& F, int layer, int m, const float* SS, const Row& gw, const NormMod& nm, bf16* H, const bf16* Y) {
    Row x[N], y[N]; float ss[N];
#pragma unroll
    for (int i = 0; i < N; ++i) { x[i] = layer == 0 ? ld_f32(row_in(F, m + i), F.lane) : ld_bf16(r16a(F, m + i), F.lane); y[i] = ld_bf16(Y + (size_t)(m + i) * D, F.lane); ss[i] = SS[m + i]; }
#pragma unroll
    for (int i = 0; i < N; ++i) { const Row xr = resid(x[i], y[i], ss[i], gw); st_bf16(layer == 0 ? r16a(F, m + i) : r16t(F, m + i), F.lane, xr); st_bf16(H + (size_t)(m + i) * D, F.lane, norm_mod(xr, nm)); }
}
__device__ __forceinline__ void px3(Frame& F, int layer, int nrows, int ssi) {
    ROWBLOCK(nrows); bf16* H = (bf16*)(F.ws + WS_H); const bf16* Y = (const bf16*)(F.ws + WS_Y);
    const float* SS = (const float*)(F.ws + WS_SS) + (size_t)ssi * MT; const float* nw = F.norm_w + layer * 4096; int bbc = -1; Row gw; NormMod nm;
    for (int m = m_lo; m < m_hi;) { const int bb = batch_of(m);
        if (bb != bbc) { gw = mk_gw(nw + 1024, modb(F, layer, bb, 2), F.lane); nm = mk_normmod(nw + 2048, modb(F, layer, bb, 3), modb(F, layer, bb, 4), F.lane); bbc = bb; }
        if (m >= MX) {
            const bf16* SL = (const bf16*)(F.ws + WS_SLAB) + (size_t)(m - MX) * D; Row y = ld_bf16(SL, F.lane);
#pragma unroll
            for (int ks = 1; ks < 4; ++ks) { const Row p = ld_bf16(SL + (size_t)ks * MC * D, F.lane);
#pragma unroll
                for (int j = 0; j < 4; ++j) y.v[j] += p.v[j]; }
            const Row x = ld_f32(row_in(F, m), F.lane); const Row xr = resid(x, y, row_ss(y), gw); st_f32(row_res(F, m), F.lane, xr); st_bf16(H + (size_t)m * D, F.lane, norm_mod(xr, nm)); m += 1; continue; }
        if (m + 1 < m_hi && batch_of(m + 1) == bb) { px3_rows<2>(F, layer, m, SS, gw, nm, H, Y); m += 2; } else { px3_rows<1>(F, layer, m, SS, gw, nm, H, Y); m += 1; } }
}
template <int N> __device__ __forceinline__ void px4_rows(Frame& F, int m, const float* SS, const Row& gw, const NormMod& nm, bf16* H, const bf16* Y) {
    Row x[N], y[N]; float ss[N];
#pragma unroll
    for (int i = 0; i < N; ++i) { x[i] = ld_bf16(r16a(F, m + i), F.lane); y[i] = ld_bf16(Y + (size_t)(m + i) * D, F.lane); ss[i] = SS[m + i]; }
#pragma unroll
    for (int i = 0; i < N; ++i) { const Row xr = resid(x[i], y[i], ss[i], gw); st_bf16(r16a(F, m + i), F.lane, xr); st_bf16(H + (size_t)(m + i) * D, F.lane, norm_mod(xr, nm)); }
}
__device__ __forceinline__ void px4(Frame& F) {
    ROWBLOCK(MT); bf16* H = (bf16*)(F.ws + WS_H); const bf16* Y = (const bf16*)(F.ws + WS_Y);
    const float* SS = (const float*)(F.ws + WS_SS) + (size_t)1 * MT; int bbc = -1; Row gw; NormMod nm;
    for (int m = m_lo; m < m_hi;) { const int bb = batch_of(m);
        if (bb != bbc) { gw = mk_gw(F.norm_w + 3 * 1024, modb(F, 0, bb, 5), F.lane); nm = mk_normmod(F.norm_w + 4096, modb(F, 1, bb, 0), modb(F, 1, bb, 1), F.lane); bbc = bb; }
        if (m >= MX) {
            const bf16* SL = (const bf16*)(F.ws + WS_SLAB) + (size_t)(m - MX) * D; Row y = ld_bf16(SL, F.lane);
#pragma unroll
            for (int ks = 1; ks < 8; ++ks) { const Row p = ld_bf16(SL + (size_t)ks * MC * D, F.lane);
#pragma unroll
                for (int j = 0; j < 4; ++j) y.v[j] += p.v[j]; }
            const Row x = ld_f32(row_res(F, m), F.lane); const Row xr = resid(x, y, row_ss(y), gw); st_bf16(H + (size_t)m * D, F.lane, norm_mod(xr, nm)); m += 1; continue; }
        if (m + 1 < m_hi && batch_of(m + 1) == bb) { px4_rows<2>(F, m, SS, gw, nm, H, Y); m += 2; } else { px4_rows<1>(F, m, SS, gw, nm, H, Y); m += 1; } }
}
template <int N> __device__ __forceinline__ void px5_rows(Frame& F, int m, const Row& nw, bf16* H, const bf16* HF, const bf16* HB, const bf16* O) {
    Row a[N], b[N], o[N];
#pragma unroll
    for (int i = 0; i < N; ++i) { a[i] = ld_bf16(HF + (size_t)(m + i) * D, F.lane); b[i] = ld_bf16(HB + (size_t)(m + i) * D, F.lane); o[i] = ld_bf16(O + (size_t)(m + i) * D, F.lane); }
#pragma unroll
    for (int i = 0; i < N; ++i) { Row h;
#pragma unroll
        for (int j = 0; j < 4; ++j) { const f32x4 s = a[i].v[j] + b[i].v[j]; float q = (s[0] * s[0] + s[1] * s[1]) + (s[2] * s[2] + s[3] * s[3]);
            q += __shfl_xor(q, 1); q += __shfl_xor(q, 2); q += __shfl_xor(q, 4); q += __shfl_xor(q, 8); q += __shfl_xor(q, 16);
            const float rstd = 1.f / sqrtf(q * (1.f / DV) + EPS);
#pragma unroll
            for (int e = 0; e < 4; ++e) h.v[j][e] = (s[e] * rstd * nw.v[j][e]) / (1.f + __builtin_amdgcn_exp2f(-1.44269504f * o[i].v[j][e])); }
        st_bf16(H + (size_t)(m + i) * D, F.lane, h); }
}
__device__ __forceinline__ void px5(Frame& F) {
    ROWBLOCK(MX); bf16* H = (bf16*)(F.ws + WS_H);
    const bf16* HF = (const bf16*)(F.ws + WS_Y); const bf16* HB = (const bf16*)(F.ws + WS_HB); const bf16* O = (const bf16*)(F.ws + WS_O);
    const Row nw = ld_f32(F.ml_norm_w, F.lane);
    for (int m = m_lo; m < m_hi;) { if (m + 1 < m_hi) { px5_rows<2>(F, m, nw, H, HF, HB, O); m += 2; } else { px5_rows<1>(F, m, nw, H, HF, HB, O); m += 1; } }
}
template <int N> __device__ __forceinline__ void px7_rows(Frame& F, int m, const float* SS, const Row& gw, const bf16* Y) {
    Row x[N], y[N]; float ss[N];
#pragma unroll
    for (int i = 0; i < N; ++i) { x[i] = ld_bf16(r16t(F, m + i), F.lane); y[i] = ld_bf16(Y + (size_t)(m + i) * D, F.lane); ss[i] = SS[m + i]; }
#pragma unroll
    for (int i = 0; i < N; ++i) st_f32(F.out + (size_t)(m + i) * D, F.lane, resid(x[i], y[i], ss[i], gw));
}
__device__ __forceinline__ void px7(Frame& F) {
    ROWBLOCK(MX); const bf16* Y = (const bf16*)(F.ws + WS_Y);
    const float* SS = (const float*)(F.ws + WS_SS) + (size_t)3 * MT; int bbc = -1; Row gw;
    for (int m = m_lo; m < m_hi;) { const int bb = batch_of(m);
        if (bb != bbc) { gw = mk_gw(F.norm_w + 4096 + 3 * 1024, modb(F, 1, bb, 5), F.lane); bbc = bb; }
        if (m + 1 < m_hi && batch_of(m + 1) == bb) { px7_rows<2>(F, m, SS, gw, Y); m += 2; } else { px7_rows<1>(F, m, SS, gw, Y); m += 1; } }
}

__device__ __forceinline__ int scan_row(int b, int r, int p) {
    if (p < CTXL) return MX + b * CTXL + (r == 0 ? p : CTXL - 1 - p);
    const int q = p - CTXL; return b * SEQ + (r == 0 ? q : SEQ - 1 - q);
}
__device__ __forceinline__ void scan_naive(Frame& F) {
    LAS float* qs = (LAS float*)(F.lds);
    LAS float* ks = qs + 32 * 64;
    LAS float* vs = ks + 32 * 64;
    LAS float* gi = vs + 32 * 128;
    LAS float* gf = gi + 32;
    LAS float* part = gf + 32;
    LAS float* pden = part + 2 * 4 * 128;
    const bf16* Q = (const bf16*)(F.ws + WS_Q); const bf16* K = (const bf16*)(F.ws + WS_K); const bf16* V = (const bf16*)(F.ws + WS_V); const float* GP = (const float*)(F.ws + WS_GP);
    const int v = F.tid & 127, dq = F.tid >> 7;
    for (int seq = F.vcu; seq < NB * NH * 2; seq += F.G) {
        const int b = seq >> 4, h = (seq >> 1) & 7, r = seq & 1;
        bf16* OUT = (bf16*)(F.ws + (r == 0 ? WS_Y : WS_HB));
        const float bi = F.ml_b_if[r * 16 + h], bfg = F.ml_b_if[r * 16 + 8 + h];
        float C[16], n[16];
#pragma unroll
        for (int j = 0; j < 16; ++j) { C[j] = 0.f; n[j] = 0.f; }
        for (int p0 = 0; p0 < CTXL + SEQ; p0 += 32) {
            __syncthreads();
            for (int i = F.tid; i < 32 * 64; i += NWAVES * 64) { const int s = i >> 6, d = i & 63; const int row = scan_row(b, r, p0 + s);
                qs[i] = row < MX ? bf2f(Q[(size_t)row * 512 + h * 64 + d]) : 0.f; ks[i] = bf2f(K[(size_t)row * 512 + h * 64 + d]); }
            for (int i = F.tid; i < 32 * 128; i += NWAVES * 64) { const int s = i >> 7, vv = i & 127; const int row = scan_row(b, r, p0 + s); vs[i] = bf2f(V[(size_t)row * 1024 + h * 128 + vv]); }
            if (F.tid < 32) { const int row = scan_row(b, r, p0 + F.tid); const float ig = GP[(size_t)row * 32 + r * 16 + h] + bi, fg = GP[(size_t)row * 32 + r * 16 + 8 + h] + bfg;
                gi[F.tid] = expf(ig); gf[F.tid] = 1.f / (1.f + expf(-fg)); }
            __syncthreads();
            for (int s = 0; s < 32; ++s) {
                const float f = gf[s], ii = gi[s] * vs[s * 128 + v], i0 = gi[s]; float pn = 0.f, pd = 0.f;
#pragma unroll
                for (int j = 0; j < 16; ++j) { const float kd = ks[s * 64 + dq * 16 + j], qd = qs[s * 64 + dq * 16 + j];
                    C[j] = f * C[j] + ii * kd; n[j] = f * n[j] + i0 * kd; pn += qd * C[j]; pd += qd * n[j]; }
                part[((s & 1) * 4 + dq) * 128 + v] = pn; if (v == 0) pden[(s & 1) * 4 + dq] = pd;
                __syncthreads();
                if (F.tid < 128 && p0 + s >= CTXL) { const LAS float* pp = part + (s & 1) * 512 + F.tid; const LAS float* dd = pden + (s & 1) * 4;
                    const float num = (pp[0] + pp[128]) + (pp[256] + pp[384]), den = (dd[0] + dd[1]) + (dd[2] + dd[3]);
                    const int row = scan_row(b, r, p0 + s);
                    OUT[(size_t)row * 1024 + h * 128 + F.tid] = (bf16)f2bf(num / fmaxf(fabsf(den), 1.f)); }
            }
        }
    }
}

typedef short bf16x8 __attribute__((ext_vector_type(8)));
typedef short v4i16_t __attribute__((ext_vector_type(4)));
typedef float f32x2_t __attribute__((ext_vector_type(2)));
typedef __bf16 bf16x2_t __attribute__((ext_vector_type(2)));
__device__ __forceinline__ unsigned cvtpk(float lo, float hi) { f32x2_t v = {lo, hi}; bf16x2_t b = __builtin_convertvector(v, bf16x2_t); return __builtin_bit_cast(unsigned, b); }
__device__ __forceinline__ v4i16_t tr16(LAS unsigned char* p) { return __builtin_amdgcn_ds_read_tr16_b64_v4i16((LAS v4i16_t*)p); }
__device__ __forceinline__ bf16x8 mk8(v4i16_t lo, v4i16_t hi) { return (bf16x8){lo[0], lo[1], lo[2], lo[3], hi[0], hi[1], hi[2], hi[3]}; }
__device__ __forceinline__ float s2f(short s) { return __builtin_bit_cast(float, (unsigned)(unsigned short)s << 16); }
__device__ __forceinline__ float logsig(float g) { return fminf(g, 0.f) - log1pf(expf(-fabsf(g))); }
constexpr int SC_KR = 0, SC_KRB = 18432, SC_VR = 36864, SC_VRB = 20480, SC_CB = 77824, SC_CBB = 11520, SC_GT = 100864, SC_GTB = 2048;
constexpr int NCHUNK = (CTXL + SEQ) / 128;
static_assert(SC_GT + 2 * SC_GTB <= RING_BYTES, "scan LDS map");

template <int RB> __device__ __forceinline__ void scan_out(LAS unsigned char* kr, LAS unsigned char* vr, LAS unsigned char* cbr, LAS float* gt, const bf16x8 q0, const bf16x8 q1, const int l15, const int g, const int tro, const int trc, bf16* op) {
                const float btv = gt[16 * RB + l15]; const float ebt = __builtin_amdgcn_exp2f(btv);
                bf16x8 pf[4];
#pragma unroll
                for (int kk = 0; kk < 4; ++kk) {
                    f32x4 pv[2];
#pragma unroll
                    for (int e = 0; e < 2; ++e) { const int sb = 2 * kk + e; pv[e] = (f32x4){0.f, 0.f, 0.f, 0.f};
                        if (sb <= RB) {
                            f32x4 acc = (f32x4){0.f, 0.f, 0.f, 0.f};
                            acc = __builtin_amdgcn_mfma_f32_16x16x32_bf16(*(LAS bf16x8*)(kr + (16 * sb + l15) * 144 + (8 * g) * 2), q0, acc, 0, 0, 0);
                            acc = __builtin_amdgcn_mfma_f32_16x16x32_bf16(*(LAS bf16x8*)(kr + (16 * sb + l15) * 144 + (32 + 8 * g) * 2), q1, acc, 0, 0, 0);
                            const f32x4 ibv = *(LAS f32x4*)(gt + 128 + 16 * sb + 4 * g);
#pragma unroll
                            for (int reg = 0; reg < 4; ++reg) { float p = acc[reg] * __builtin_amdgcn_exp2f(btv + ibv[reg]);
                                if (sb == RB && 4 * g + reg > l15) p = 0.f; pv[e][reg] = p; }
                        } }
                    v4u pk; pk.x = cvtpk(pv[0][0], pv[0][1]); pk.y = cvtpk(pv[0][2], pv[0][3]); pk.z = cvtpk(pv[1][0], pv[1][1]); pk.w = cvtpk(pv[1][2], pv[1][3]);
                    pf[kk] = __builtin_bit_cast(bf16x8, pk);
                }
                f32x4 num[5];
#pragma unroll
                for (int vb = 0; vb < 5; ++vb) {
                    f32x4 oa = (f32x4){0.f, 0.f, 0.f, 0.f}, qa = (f32x4){0.f, 0.f, 0.f, 0.f};
#pragma unroll
                    for (int kk = 0; kk < 4; ++kk) if (2 * kk <= RB) {
                        const v4i16_t lo = tr16(vr + (32 * kk + tro) * 160 + (16 * vb + trc) * 2), hi = tr16(vr + (32 * kk + 16 + tro) * 160 + (16 * vb + trc) * 2);
                        oa = __builtin_amdgcn_mfma_f32_16x16x32_bf16(mk8(lo, hi), pf[kk], oa, 0, 0, 0); }
                    qa = __builtin_amdgcn_mfma_f32_16x16x32_bf16(*(LAS bf16x8*)(cbr + (16 * vb + l15) * 144 + (8 * g) * 2), q0, qa, 0, 0, 0);
                    qa = __builtin_amdgcn_mfma_f32_16x16x32_bf16(*(LAS bf16x8*)(cbr + (16 * vb + l15) * 144 + (32 + 8 * g) * 2), q1, qa, 0, 0, 0);
                    num[vb] = oa + qa * ebt;
                }
                const float den = __shfl(num[4][0], l15);
                const float sc = 1.f / fmaxf(fabsf(den), 1.f);
                #pragma unroll
                for (int vb = 0; vb < 4; ++vb) { v2u o; o.x = cvtpk(num[vb][0] * sc, num[vb][1] * sc); o.y = cvtpk(num[vb][2] * sc, num[vb][3] * sc); *(v2u*)(op + 16 * vb) = o; }

}
template <int RB> __device__ __forceinline__ void scan_update(LAS unsigned char* kr, LAS unsigned char* vr, LAS unsigned char* cbw, LAS float* gt, f32x4 (&cacc)[3], const int l15, const int g, const int tro, const int trc) {
    constexpr int W = RB < 4 ? RB : 11 - RB, nvb = W < 4 ? 3 : 2, vb0 = W < 4 ? 0 : 3, db = W & 3;
            const float a = gt[384];
#pragma unroll
            for (int i = 0; i < 3; ++i) cacc[i] = cacc[i] * a;
#pragma unroll
            for (int kk = 0; kk < 4; ++kk) {
                const v4i16_t klo = tr16(kr + (32 * kk + tro) * 144 + (16 * db + trc) * 2), khi = tr16(kr + (32 * kk + 16 + tro) * 144 + (16 * db + trc) * 2);
                const f32x4 wlo = *(LAS f32x4*)(gt + 256 + 32 * kk + 4 * g), whi = *(LAS f32x4*)(gt + 256 + 32 * kk + 16 + 4 * g);
                v4u pk; pk.x = cvtpk(s2f(klo[0]) * wlo[0], s2f(klo[1]) * wlo[1]); pk.y = cvtpk(s2f(klo[2]) * wlo[2], s2f(klo[3]) * wlo[3]);
                pk.z = cvtpk(s2f(khi[0]) * whi[0], s2f(khi[1]) * whi[1]); pk.w = cvtpk(s2f(khi[2]) * whi[2], s2f(khi[3]) * whi[3]);
                const bf16x8 bfrag = __builtin_bit_cast(bf16x8, pk);
#pragma unroll
                for (int i = 0; i < 3; ++i) if (i < nvb) { const int vb = vb0 + i;
                    const v4i16_t lo = tr16(vr + (32 * kk + tro) * 160 + (16 * vb + trc) * 2), hi = tr16(vr + (32 * kk + 16 + tro) * 160 + (16 * vb + trc) * 2);
                    cacc[i] = __builtin_amdgcn_mfma_f32_16x16x32_bf16(mk8(lo, hi), bfrag, cacc[i], 0, 0, 0); }
            }
#pragma unroll
            for (int i = 0; i < 3; ++i) if (i < nvb) { const int vb = vb0 + i;
#pragma unroll
                for (int reg = 0; reg < 4; ++reg) *(LAS bf16*)(cbw + (16 * vb + 4 * g + reg) * 144 + (16 * db + l15) * 2) = (bf16)(cvtpk(cacc[i][reg], 0.f) & 0xffffu); }
        }
__device__ __forceinline__ void scan_mfma(Frame& F) {
    const int lane = F.lane, w = F.wave, g = lane >> 4, l15 = lane & 15;
    LAS unsigned char* lds = F.lds;
    const bf16* Qg = (const bf16*)(F.ws + WS_Q); const bf16* Kg = (const bf16*)(F.ws + WS_K); const bf16* Vg = (const bf16*)(F.ws + WS_V); const float* GP = (const float*)(F.ws + WS_GP);
    const int rb = w < 4 ? w : 11 - w;
    const int tro = 4 * g + (l15 >> 2), trc = 4 * (l15 & 3);
    for (int unit = F.vcu; unit < 256; unit += F.G) {
        const int b = unit >> 5, h = (unit >> 2) & 7, r = (unit >> 1) & 1, vh = unit & 1;
        bf16* OUT = (bf16*)(F.ws + (r == 0 ? WS_Y : WS_HB));
        const float bi = F.ml_b_if[r * 16 + h], bfg = F.ml_b_if[r * 16 + 8 + h];
        __syncthreads();
        { const int bufi = F.tid >> 8, s = (F.tid >> 1) & 127, half = F.tid & 1;
          *(LAS v4u*)(lds + SC_VR + bufi * SC_VRB + s * 160 + 128 + half * 16) = half == 0 ? (v4u){0x00003F80u, 0u, 0u, 0u} : (v4u){0u, 0u, 0u, 0u}; }
        f32x4 cacc[3];
#pragma unroll
        for (int i = 0; i < 3; ++i) cacc[i] = (f32x4){0.f, 0.f, 0.f, 0.f};
        v4u kp[2], vp[2], grp = (v4u){0u, 0u, 0u, 0u}; bf16x8 qf[2];
        qf[0] = (bf16x8){0, 0, 0, 0, 0, 0, 0, 0}; qf[1] = qf[0];
        float* grec = (float*)(F.ws + WS_GREC) + (size_t)unit * NCHUNK * 388;
        for (int c = w; c < NCHUNK; c += NWAVES) {
            const size_t row0 = (size_t)scan_row(b, r, c * 128 + 2 * lane), row1 = (size_t)scan_row(b, r, c * 128 + 2 * lane + 1);
            const float lf0 = logsig(GP[row0 * 32 + r * 16 + 8 + h] + bfg), lf1 = logsig(GP[row1 * 32 + r * 16 + 8 + h] + bfg), i0 = GP[row0 * 32 + r * 16 + h] + bi, i1 = GP[row1 * 32 + r * 16 + h] + bi;
            float incl = lf0 + lf1;
#pragma unroll
            for (int o = 1; o < 64; o <<= 1) { const float t = __shfl_up(incl, o); if (lane >= o) incl += t; }
            const float b0 = incl - lf1, b1 = incl, blast = __shfl(incl, 63);
            float* gr = grec + (size_t)c * 388;
            *(f32x2_t*)(gr + 2 * lane) = (f32x2_t){b0 * 1.44269504f, b1 * 1.44269504f}; *(f32x2_t*)(gr + 128 + 2 * lane) = (f32x2_t){(i0 - b0) * 1.44269504f, (i1 - b1) * 1.44269504f};
            *(f32x2_t*)(gr + 256 + 2 * lane) = (f32x2_t){expf(blast - b0 + i0), expf(blast - b1 + i1)};
            if (lane == 0) gr[384] = expf(blast);
        }
        asm volatile("s_waitcnt vmcnt(0)" ::: "memory");
        __syncthreads();
#define SC_PREFETCH(c) do { const int p0_ = (c) * 128; \
            _Pragma("unroll") for (int i_ = 0; i_ < 2; ++i_) { const int idx_ = F.tid + 512 * i_, s_ = idx_ >> 3, part_ = idx_ & 7; const size_t row_ = (size_t)scan_row(b, r, p0_ + s_); \
                kp[i_] = *(const v4u*)(Kg + row_ * 512 + h * 64 + part_ * 8); vp[i_] = *(const v4u*)(Vg + row_ * 1024 + h * 128 + vh * 64 + part_ * 8); } \
            if ((c) >= 2) { const size_t row_ = (size_t)scan_row(b, r, p0_ + 16 * rb + l15); \
                qf[0] = *(const bf16x8*)(Qg + row_ * 512 + h * 64 + 8 * g); qf[1] = *(const bf16x8*)(Qg + row_ * 512 + h * 64 + 32 + 8 * g); } \
            if (F.tid < 97) grp = *(const v4u*)(grec + (size_t)(c) * 388 + 4 * F.tid); } while (0)
        SC_PREFETCH(0);
        for (int c = 0; c < NCHUNK; ++c) {
            LAS unsigned char* kr = lds + SC_KR + (c & 1) * SC_KRB; LAS unsigned char* vr = lds + SC_VR + (c & 1) * SC_VRB;
            LAS unsigned char* cbr = lds + SC_CB + (c & 1) * SC_CBB; LAS unsigned char* cbw = lds + SC_CB + ((c + 1) & 1) * SC_CBB;
            LAS float* gt = (LAS float*)(lds + SC_GT + (c & 1) * SC_GTB);
#pragma unroll
            for (int i = 0; i < 2; ++i) { const int idx = F.tid + 512 * i, s = idx >> 3, part = idx & 7;
                *(LAS v4u*)(kr + s * 144 + part * 16) = kp[i]; *(LAS v4u*)(vr + s * 160 + part * 16) = vp[i]; }
            const bf16x8 q0 = qf[0], q1 = qf[1];
            if (F.tid < 97) *(LAS v4u*)((LAS unsigned char*)gt + 16 * F.tid) = grp;
            if (c + 1 < NCHUNK) SC_PREFETCH(c + 1);
            __syncthreads();
            const size_t orow = (size_t)scan_row(b, r, c * 128 + 16 * rb + l15);
            if (c >= 2) {
                bf16* op = OUT + orow * 1024 + h * 128 + vh * 64 + 4 * g;
                switch (rb) {
                    case 0: scan_out<0>(kr, vr, cbr, gt, q0, q1, l15, g, tro, trc, op); break;
                    case 1: scan_out<1>(kr, vr, cbr, gt, q0, q1, l15, g, tro, trc, op); break;
                    case 2: scan_out<2>(kr, vr, cbr, gt, q0, q1, l15, g, tro, trc, op); break;
                    case 3: scan_out<3>(kr, vr, cbr, gt, q0, q1, l15, g, tro, trc, op); break;
                    case 4: scan_out<4>(kr, vr, cbr, gt, q0, q1, l15, g, tro, trc, op); break;
                    case 5: scan_out<5>(kr, vr, cbr, gt, q0, q1, l15, g, tro, trc, op); break;
                    case 6: scan_out<6>(kr, vr, cbr, gt, q0, q1, l15, g, tro, trc, op); break;
                    default: scan_out<7>(kr, vr, cbr, gt, q0, q1, l15, g, tro, trc, op); break;
                }
            }
            switch (rb) {
                case 0: scan_update<0>(kr, vr, cbw, gt, cacc, l15, g, tro, trc); break;
                case 1: scan_update<1>(kr, vr, cbw, gt, cacc, l15, g, tro, trc); break;
                case 2: scan_update<2>(kr, vr, cbw, gt, cacc, l15, g, tro, trc); break;
                case 3: scan_update<3>(kr, vr, cbw, gt, cacc, l15, g, tro, trc); break;
                case 4: scan_update<4>(kr, vr, cbw, gt, cacc, l15, g, tro, trc); break;
                case 5: scan_update<5>(kr, vr, cbw, gt, cacc, l15, g, tro, trc); break;
                case 6: scan_update<6>(kr, vr, cbw, gt, cacc, l15, g, tro, trc); break;
                default: scan_update<7>(kr, vr, cbw, gt, cacc, l15, g, tro, trc); break;
            }
        }
#undef SC_PREFETCH
    }
}

struct Args { const float* in[17]; float* out; unsigned char* ws; int ph_lo, ph_hi, li, pad; };
__global__ void __launch_bounds__(NWAVES * 64, 2) fwd_kernel(Args args) {
    extern __shared__ __attribute__((aligned(16))) unsigned char lds[];
    Frame F;
    F.lds = (LAS unsigned char*)lds;
    F.MISC = (volatile LAS unsigned*)(F.lds + MISC_OFF);
    F.tid = threadIdx.x; F.lane = F.tid & 63; F.wave = __builtin_amdgcn_readfirstlane(F.tid >> 6);
    F.G = gridDim.x; { const int bx = blockIdx.x; F.vcu = (F.G % 8 == 0) ? (bx % 8) * (F.G / 8) + bx / 8 : bx; }
    F.ws = args.ws; F.out = args.out; F.ctl = (gu32*)(args.ws + WS_CTL);
    F.x = args.in[0]; F.c = args.in[1]; F.ctx = args.in[2]; F.cctx = args.in[3]; F.norm_w = args.in[4]; F.mod_w = args.in[5]; F.mod_b = args.in[6]; F.mlp_w1 = args.in[7]; F.mlp_w2 = args.in[8];
    F.conv_w_in = args.in[9]; F.conv_w = args.in[10]; F.conv_w_out = args.in[11]; F.ml_w_qkvo = args.in[12]; F.ml_w_if = args.in[13]; F.ml_b_if = args.in[14]; F.ml_norm_w = args.in[15]; F.ml_w_out = args.in[16];
    for (int u = F.tid; u < (LDS_BYTES - LDSCTL_OFF) / 4; u += NWAVES * 64) ((LAS unsigned*)(F.lds + LDSCTL_OFF))[u] = 0u;
    __syncthreads();
    XcdBarrier bar; bar.bar = (unsigned*)(F.ctl + CW_BAR); bar.x = 0; bar.st = nullptr;
    if (N_LAUNCHES == 1) bar = xcd_barrier_post((unsigned*)(F.ctl + CW_BAR), F.MISC + 8);
    const int lo = args.ph_lo, hi = args.ph_hi;
#define IN(k) (lo <= (k) && (k) < hi)
#define SEAM(k) do { if (IN(k) && IN((k) + 1)) xcd_barrier(bar); } while (0)
    bf16* const H = (bf16*)(F.ws + WS_H); bf16* const Y = (bf16*)(F.ws + WS_Y); bf16* const BIG = (bf16*)(F.ws + WS_BIG); float* const SS = (float*)(F.ws + WS_SS);

    if (IN(0)) { p0_prologue(F); if (PROBE & 8) { xcd_barrier(bar); p0_prologue(F); } } SEAM(0);
    if (IN(1)) { px1(F); if (PROBE & 1) { xcd_barrier(bar); px1(F); } } SEAM(1);
    if (IN(2)) {
        pg8::Gemm g{H, (const bf16*)(F.ws + WS_WIN), MT, 3072, D}; pg8::StaticOrder S; S.init(MT, 3072, F.G, (int)blockIdx.x);
        pg8::EpiConvIn E{BIG};
        pg8::gemm_phase<pg8::EpiConvIn, pg8::StaticOrder, true, true>(F.lds + RING_OFF, g, S, E); } SEAM(2);
    if (IN(3)) { px2(F); if (PROBE & 1) { xcd_barrier(bar); px2(F); } } SEAM(3);
    if (IN(4)) {
        pg8::Gemm g{H, (const bf16*)(F.ws + WS_WOUT0), MT, D, D}; pg8::SplitOrder S; S.init(D, 4, F.G, (int)blockIdx.x);
        pg8::EpiBf16SS E{Y, D, SS, (bf16*)(F.ws + WS_SLAB), D / 64 / 4};
        pg8::gemm_phase<pg8::EpiBf16SS, pg8::SplitOrder, true, true>(F.lds + RING_OFF, g, S, E); } SEAM(4);
    if (IN(5)) { px3(F, 0, MT, 0); } SEAM(5);
    if (IN(6)) {
        pg8::Gemm g{H, (const bf16*)(F.ws + WS_W1A), MT, FF, D}; pg8::StaticOrder S; S.init(MT, FF, F.G, (int)blockIdx.x);
        pg8::EpiBf16<2> E{BIG, FF};
        pg8::gemm_phase<pg8::EpiBf16<2>, pg8::StaticOrder, true, true>(F.lds + RING_OFF, g, S, E); } SEAM(6);
    if (IN(7)) {
        pg8::Gemm g{BIG, (const bf16*)(F.ws + WS_W2A), MT, D, FF}; pg8::SplitOrder S; S.init(FF, 8, F.G, (int)blockIdx.x);
        pg8::EpiBf16SS E{Y, D, SS + MT, (bf16*)(F.ws + WS_SLAB), FF / 64 / 8};
        pg8::gemm_phase<pg8::EpiBf16SS, pg8::SplitOrder, true, true>(F.lds + RING_OFF, g, S, E); } SEAM(7);
    if (IN(8)) { px4(F); } SEAM(8);
    if (IN(9)) {
        pg8::Gemm g{H, (const bf16*)(F.ws + WS_WQKVO), MT, NQKVO, D}; pg8::QkvoOrder S; S.init(F.G, (int)blockIdx.x);
        pg8::EpiQkvo E{(bf16*)(F.ws + WS_Q), (bf16*)(F.ws + WS_K), (bf16*)(F.ws + WS_V), (bf16*)(F.ws + WS_O), (float*)(F.ws + WS_GP)};
        pg8::gemm_phase<pg8::EpiQkvo, pg8::QkvoOrder, true, true>(F.lds + RING_OFF, g, S, E); } SEAM(9);
    #if defined(SCAN_NAIVE)
    if (IN(10)) { scan_naive(F); } SEAM(10);
#else
    if (IN(10)) { scan_mfma(F); if (PROBE & 2) { xcd_barrier(bar); scan_mfma(F); } } SEAM(10);
#endif
    if (IN(11)) { px5(F); if (PROBE & 1) { xcd_barrier(bar); px5(F); } } SEAM(11);
    if (IN(12)) {
        pg8::Gemm g{H, (const bf16*)(F.ws + WS_WOUT1), MX, D, D}; pg8::StaticOrder S; S.init(MX, D, F.G, (int)blockIdx.x, D);
        pg8::EpiBf16SS E{Y, D, SS + 2 * MT, nullptr, 1};
        pg8::gemm_phase<pg8::EpiBf16SS, pg8::StaticOrder, true, true>(F.lds + RING_OFF, g, S, E); } SEAM(12);
    if (IN(13)) { px3(F, 1, MX, 2); } SEAM(13);
    if (IN(14)) {
        pg8::Gemm g{H, (const bf16*)(F.ws + WS_W1B), MX, FF, D}; pg8::StaticOrder S; S.init(MX, FF, F.G, (int)blockIdx.x);
        pg8::EpiBf16<2> E{BIG, FF};
        pg8::gemm_phase<pg8::EpiBf16<2>, pg8::StaticOrder, true, true>(F.lds + RING_OFF, g, S, E);
        if (PROBE & 4) { xcd_barrier(bar); pg8::gemm_phase<pg8::EpiBf16<2>, pg8::StaticOrder, true, true>(F.lds + RING_OFF, g, S, E); } } SEAM(14);
    if (IN(15)) {
        pg8::Gemm g{BIG, (const bf16*)(F.ws + WS_W2B), MX, D, FF}; pg8::StaticOrder S; S.init(MX, D, F.G, (int)blockIdx.x, FF);
        pg8::EpiBf16SS E{Y, D, SS + 3 * MT, nullptr, 1};
        pg8::gemm_phase<pg8::EpiBf16SS, pg8::StaticOrder, true, true>(F.lds + RING_OFF, g, S, E); } SEAM(15);
    if (IN(16)) { px7(F); }
#undef IN
#undef SEAM
}

extern "C" void kernel_launch(void* const* d_in, const int* in_sizes, int n_in, void* d_out, int out_size, void* d_ws, size_t ws_size, hipStream_t stream) {
    static int grid = 0;
    if (grid == 0) {
        if (n_in != 17 || in_sizes[0] != MX * D || out_size != MX * D || ws_size < WS_END) { fprintf(stderr, "kernel_launch: unexpected problem (n_in %d, in0 %d, out %d, ws %zu < %zu); nothing launched\n", n_in, n_in > 0 ? in_sizes[0] : -1, out_size, ws_size, (size_t)WS_END); grid = -1; return; }
        int dev = 0, cus = 0, per_cu = 0;
        if (hipGetDevice(&dev) != hipSuccess || hipDeviceGetAttribute(&cus, hipDeviceAttributeMultiprocessorCount, dev) != hipSuccess) { fprintf(stderr, "kernel_launch: device query failed\n"); grid = -1; return; }
        if (hipFuncSetAttribute((const void*)fwd_kernel, hipFuncAttributeMaxDynamicSharedMemorySize, LDS_BYTES) != hipSuccess) { fprintf(stderr, "kernel_launch: hipFuncSetAttribute failed\n"); grid = -1; return; }
        if (hipOccupancyMaxActiveBlocksPerMultiprocessor(&per_cu, (const void*)fwd_kernel, NWAVES * 64, LDS_BYTES) != hipSuccess || per_cu < 1) { fprintf(stderr, "kernel_launch: occupancy query says %d blocks per CU\n", per_cu); per_cu = 1; }
        (void)hipGetLastError();
        grid = cus;
    }
    if (grid < 0) return;
    if (hipMemsetAsync((char*)d_ws + WS_CTL, 0, CTL_ZERO_BYTES, stream) != hipSuccess) { fprintf(stderr, "kernel_launch: memset failed\n"); return; }
    Args a{};
    for (int i = 0; i < 17; ++i) a.in[i] = (const float*)d_in[i];
    a.out = (float*)d_out; a.ws = (unsigned char*)d_ws;
    for (int li = 0; li < N_LAUNCHES; ++li) {
        a.ph_lo = (N_LAUNCHES == 1) ? 0 : li; a.ph_hi = (N_LAUNCHES == 1) ? N_PHASES : li + 1; a.li = li;
        hipLaunchKernelGGL(fwd_kernel, dim3(grid), dim3(NWAVES * 64), LDS_BYTES, stream, a);
        const hipError_t le = hipPeekAtLastError();
        if (le != hipSuccess) { fprintf(stderr, "kernel_launch: launch %d failed: %s\n", li, hipGetErrorName(le)); break; }
    }
}
```

```cpp
#include <hip/hip_runtime.h>
#include <cstdio>
#include <cstdint>
namespace pg8 {
#define PG8_LAS __attribute__((address_space(3)))
typedef unsigned short bf16_t;
typedef short bf16x8 __attribute__((ext_vector_type(8)));
typedef float f32x4 __attribute__((ext_vector_type(4)));
typedef unsigned u32x4 __attribute__((ext_vector_type(4)));
constexpr int BM = 256, BK = 64, HALF = 128, HTB = HALF * BK * 2  , STAGE_BYTES = 8 * HTB, NXCD = 8, WGM = 8;

__host__ __device__ __forceinline__ int lds_byte(int r, int c) { const int st = (r >> 4) * 2 + (c >> 5), rr = r & 15, cc = c & 31, ob = rr * 64 + cc * 2; return st * 1024 + (ob ^ (((ob >> 9) & 1) << 5)); }
__host__ __device__ __forceinline__ void stage_rc(int b, int& R, int& C) { const int st = b / 1024, sb = b % 1024, swz = sb ^ (((sb >> 9) & 1) << 5); R = (st >> 1) * 16 + swz / 64; C = (st & 1) * 32 + (swz % 64) / 2; }
__host__ __device__ __forceinline__ int perm32(int rho) { const int n = rho >> 4, i = rho & 15; return 8 * (i >> 2) + 4 * n + (i & 3); }

struct Unit { int pm, pn, kt0, nkt; };
struct Gemm { const bf16_t* A; const bf16_t* Bt; int M, N, K; };

struct StaticOrder {
    int nM, nN, nwg, G, c, nkt, rev;
    __host__ __device__ void init(int M, int N, int G_, int c_, int K = 1024, int rev_ = 0) { nM = M / BM; nN = N / BM; nwg = nM * nN; G = G_; c = c_; nkt = K / BK; rev = (rev_ && nwg % G_ == 0) ? 1 : 0; }
    __host__ __device__ bool next(int i, Unit& u) const {
        if (rev && (long)i * G >= nwg) return false;
        const long L = rev ? (long)(nwg / G - 1 - i) * G + c : (long)i * G + c; if (L >= nwg) return false;
        int wgid = (int)L; { const int q = nwg / NXCD, r = nwg % NXCD, xcd = wgid % NXCD, off = wgid / NXCD; wgid = (xcd < r ? xcd * (q + 1) : r * (q + 1) + (xcd - r) * q) + off; }
        const int nig = WGM * nN, gid = wgid / nig, fm = gid * WGM, gsz = (nM - fm) < WGM ? (nM - fm) : WGM;
        u.pm = fm + ((wgid % nig) % gsz); u.pn = (wgid % nig) / gsz; u.kt0 = 0; u.nkt = nkt; return true;
    }
    __device__ __forceinline__ void a_ready(const Unit&) const {}
    __device__ __forceinline__ void done(const Unit&) const {}
};

__device__ __forceinline__ unsigned cvt_pk_bf16(float lo, float hi) { unsigned r; asm volatile("v_cvt_pk_bf16_f32 %0, %1, %2" : "=v"(r) : "v"(lo), "v"(hi)); return r; }

template <int ACT> struct EpiBf16 {
    static constexpr bool PERM = true, AFTER_DRAIN = false;
    bf16_t* O; int ldc;
    __device__ __forceinline__ void operator()(const f32x4 (&acc)[2][2][4][2], const Unit& u, int wr, int wc, int fr, int fq) const {
        const int row0 = u.pm * BM + wr * 64 + fr, col0 = u.pn * BM + wc * 32 + 8 * fq;
#pragma unroll
        for (int ai = 0; ai < 2; ++ai)
#pragma unroll
            for (int m = 0; m < 4; ++m) { bf16_t* rowp = O + (size_t)(row0 + ai * HALF + m * 16) * ldc + col0;
#pragma unroll
                for (int bj = 0; bj < 2; ++bj) { f32x4 v0 = acc[ai][bj][m][0], v1 = acc[ai][bj][m][1];
                    if (ACT == 2) {
#pragma unroll
                        for (int e = 0; e < 4; ++e) { float a = fmaxf(v0[e], 0.f), b = fmaxf(v1[e], 0.f); v0[e] = a * a; v1[e] = b * b; } }
                    u32x4 w; w.x = cvt_pk_bf16(v0[0], v0[1]); w.y = cvt_pk_bf16(v0[2], v0[3]); w.z = cvt_pk_bf16(v1[0], v1[1]); w.w = cvt_pk_bf16(v1[2], v1[3]);
                    *(u32x4*)(rowp + bj * HALF) = w; } }
    }
};
struct EpiConvIn {
    static constexpr bool PERM = true, AFTER_DRAIN = false;
    bf16_t* O;
    __device__ __forceinline__ void operator()(const f32x4 (&acc)[2][2][4][2], const Unit& u, int wr, int wc, int fr, int fq) const {
        const int row0 = u.pm * BM + wr * 64 + fr;
        if (u.pn < 8) {
            const int col0 = u.pn * 128 + wc * 32 + 8 * fq;
#pragma unroll
            for (int ai = 0; ai < 2; ++ai)
#pragma unroll
                for (int m = 0; m < 4; ++m) { const f32x4 v0 = acc[ai][0][m][0] * acc[ai][1][m][0], v1 = acc[ai][0][m][1] * acc[ai][1][m][1];
                    u32x4 w; w.x = cvt_pk_bf16(v0[0], v0[1]); w.y = cvt_pk_bf16(v0[2], v0[3]); w.z = cvt_pk_bf16(v1[0], v1[1]); w.w = cvt_pk_bf16(v1[2], v1[3]);
                    *(u32x4*)(O + (size_t)(row0 + ai * HALF + m * 16) * 2048 + col0) = w; }
        } else {
            const int col0 = 1024 + (u.pn - 8) * BM + wc * 32 + 8 * fq;
#pragma unroll
            for (int ai = 0; ai < 2; ++ai)
#pragma unroll
                for (int m = 0; m < 4; ++m) { bf16_t* rowp = O + (size_t)(row0 + ai * HALF + m * 16) * 2048 + col0;
#pragma unroll
                    for (int bj = 0; bj < 2; ++bj) { const f32x4 v0 = acc[ai][bj][m][0], v1 = acc[ai][bj][m][1];
                        u32x4 w; w.x = cvt_pk_bf16(v0[0], v0[1]); w.y = cvt_pk_bf16(v0[2], v0[3]); w.z = cvt_pk_bf16(v1[0], v1[1]); w.w = cvt_pk_bf16(v1[2], v1[3]);
                        *(u32x4*)(rowp + bj * HALF) = w; } }
        }
    }
};
struct EpiBf16SS {
    static constexpr bool PERM = true, AFTER_DRAIN = false;
    bf16_t* O; int ldc; float* ss; bf16_t* slab; int skt;
    __device__ __forceinline__ void operator()(const f32x4 (&acc)[2][2][4][2], const Unit& u, int wr, int wc, int fr, int fq) const {
        const int row0 = u.pm * BM + wr * 64 + fr, col0 = u.pn * BM + wc * 32 + 8 * fq;
        const bool piece = slab != nullptr && u.pm >= 128;
        bf16_t* base = piece ? slab + ((long)(u.kt0 / skt) * 2048 - 32768) * 1024 : O;
#pragma unroll
        for (int ai = 0; ai < 2; ++ai)
#pragma unroll
            for (int m = 0; m < 4; ++m) { const int row = row0 + ai * HALF + m * 16; bf16_t* rowp = base + (size_t)row * ldc + col0; float s = 0.f;
#pragma unroll
                for (int bj = 0; bj < 2; ++bj) { const f32x4 v0 = acc[ai][bj][m][0], v1 = acc[ai][bj][m][1];
                    s += (v0[0] * v0[0] + v0[1] * v0[1]) + (v0[2] * v0[2] + v0[3] * v0[3]) + (v1[0] * v1[0] + v1[1] * v1[1]) + (v1[2] * v1[2] + v1[3] * v1[3]);
                    u32x4 w; w.x = cvt_pk_bf16(v0[0], v0[1]); w.y = cvt_pk_bf16(v0[2], v0[3]); w.z = cvt_pk_bf16(v1[0], v1[1]); w.w = cvt_pk_bf16(v1[2], v1[3]);
                    *(u32x4*)(rowp + bj * HALF) = w; }
                if (!piece) { s += __shfl_xor(s, 16); s += __shfl_xor(s, 32);
                    if (fq == 0) (void)__hip_atomic_fetch_add(ss + row, s, __ATOMIC_RELAXED, __HIP_MEMORY_SCOPE_AGENT); } }
    }
};
struct EpiQkvo {
    static constexpr bool PERM = true, AFTER_DRAIN = false;
    bf16_t *Q, *K, *V, *O; float* GP;
    __device__ __forceinline__ void operator()(const f32x4 (&acc)[2][2][4][2], const Unit& u, int wr, int wc, int fr, int fq) const {
        const int row0 = u.pm * BM + wr * 64 + fr;
        if (u.pn == 12) {
            if (wc == 0) {
#pragma unroll
                for (int ai = 0; ai < 2; ++ai)
#pragma unroll
                    for (int m = 0; m < 4; ++m) { float* rowp = GP + (size_t)(row0 + ai * HALF + m * 16) * 32 + 8 * fq;
                        *(f32x4*)(rowp) = acc[ai][0][m][0]; *(f32x4*)(rowp + 4) = acc[ai][0][m][1]; }
            }
            return;
        }
        bf16_t* base; int ldc, colt; float sc = 1.f;
        if (u.pn < 2) { base = Q; ldc = 512; colt = u.pn * BM; sc = 0.125f; }
        else if (u.pn < 4) { base = K; ldc = 512; colt = (u.pn - 2) * BM; }
        else if (u.pn < 8) { base = V; ldc = 1024; colt = (u.pn - 4) * BM; }
        else { base = O; ldc = 1024; colt = (u.pn - 8) * BM; }
        const int col0 = colt + wc * 32 + 8 * fq;
#pragma unroll
        for (int ai = 0; ai < 2; ++ai)
#pragma unroll
            for (int m = 0; m < 4; ++m) { bf16_t* rowp = base + (size_t)(row0 + ai * HALF + m * 16) * ldc + col0;
#pragma unroll
                for (int bj = 0; bj < 2; ++bj) { const f32x4 v0 = acc[ai][bj][m][0] * sc, v1 = acc[ai][bj][m][1] * sc;
                    u32x4 w; w.x = cvt_pk_bf16(v0[0], v0[1]); w.y = cvt_pk_bf16(v0[2], v0[3]); w.z = cvt_pk_bf16(v1[0], v1[1]); w.w = cvt_pk_bf16(v1[2], v1[3]);
                    *(u32x4*)(rowp + bj * HALF) = w; } }
    }
};
struct QkvoOrder {
    StaticOrder so;
    __host__ __device__ void init(int G_, int c_) { so.init(32768, 3328, G_, c_); }
    __host__ __device__ bool next(int i, Unit& u) const {
        const long L = (long)i * so.G + so.c;
        if (L < so.nwg) return so.next(i, u);
        const int e = (int)(L - so.nwg); if (e >= 56) return false;
        const int ti = e >> 3; u.pm = 128 + (e & 7); u.pn = ti < 6 ? 2 + ti : 12; u.kt0 = 0; u.nkt = so.nkt; return true;
    }
    __device__ __forceinline__ void a_ready(const Unit&) const {}
    __device__ __forceinline__ void done(const Unit&) const {}
};

struct SplitOrder {
    StaticOrder so; int nks, skt;
    __host__ __device__ void init(int K, int nks_, int G_, int c_, int rev_ = 0) { so.init(32768, 1024, G_, c_, K, rev_); nks = nks_; skt = K / BK / nks_; }
    __host__ __device__ bool next(int i, Unit& u) const {
        const long L = (long)i * so.G + so.c;
        if (L < so.nwg) return so.next(i, u);
        const int e = (int)(L - so.nwg); if (e >= 32 * nks) return false;
        u.pm = 128 + (e & 7); u.pn = (e >> 3) & 3; u.kt0 = (e >> 5) * skt; u.nkt = skt; return true;
    }
    __device__ __forceinline__ void a_ready(const Unit&) const {}
    __device__ __forceinline__ void done(const Unit&) const {}
};

template <class Epi, class Sched, bool ALIGN_EPI = false, bool SP2 = false>
__device__ __forceinline__ void gemm_phase(PG8_LAS unsigned char* lds, const Gemm g, const Sched& S, const Epi& E) {
    const int tid = threadIdx.x, wid = __builtin_amdgcn_readfirstlane(tid >> 6), lane = tid & 63, wr = wid >> 2, wc = wid & 3, fr = lane & 15, fq = lane >> 4;
    const int K = g.K;
    unsigned voffA[2], voffB[2];
#pragma unroll
    for (int i = 0; i < 2; ++i) { int R, C; stage_rc(tid * 16 + i * 8192, R, C); const int Rb = Epi::PERM ? ((R & ~31) + perm32(R & 31)) : R;
        voffA[i] = (unsigned)(R * K + C) * 2u; voffB[i] = (unsigned)(Rb * K + C) * 2u; }
    const size_t kstep = (size_t)(BK * 2);
    const size_t hstep = (size_t)HALF * K * 2;
    const size_t tstep = 2 * hstep;
    const unsigned ldsw = (unsigned)wid * 1024u;
    const int aoff = lds_byte(wr * 64 + fr, fq * 8), boff = lds_byte(wc * 32 + fr, fq * 8);
#define PG8_SA(b, h) (((b) * 2 + (h)) * HTB)
#define PG8_SB(b, h) ((4 + (b) * 2 + (h)) * HTB)
#define PG8_STAGE(bufoff, gbase, voff) do { _Pragma("unroll") for (int _i = 0; _i < 2; ++_i) \
        __builtin_amdgcn_global_load_lds((const unsigned*)((const char*)(gbase) + (voff)[_i]), (PG8_LAS unsigned*)(lds + (bufoff) + ldsw + _i * 8192), 16, 0, 0); } while (0)
#define PG8_LDA(dst, b, h) do { _Pragma("unroll") for (int m = 0; m < 4; ++m) _Pragma("unroll") for (int k = 0; k < 2; ++k) dst[m][k] = *(const PG8_LAS bf16x8*)(lds + PG8_SA(b, h) + aoff + m * 2048 + k * 1024); } while (0)
#define PG8_LDB(dst, b, h) do { _Pragma("unroll") for (int n = 0; n < 2; ++n) _Pragma("unroll") for (int k = 0; k < 2; ++k) dst[n][k] = *(const PG8_LAS bf16x8*)(lds + PG8_SB(b, h) + boff + n * 2048 + k * 1024); } while (0)
#define PG8_MMA(ai, bj, At, Bt) do { __builtin_amdgcn_s_setprio(1); _Pragma("unroll") for (int m = 0; m < 4; ++m) _Pragma("unroll") for (int n = 0; n < 2; ++n) _Pragma("unroll") for (int k = 0; k < 2; ++k) \
        acc[ai][bj][m][n] = __builtin_amdgcn_mfma_f32_16x16x32_bf16(Bt[n][k], At[m][k], acc[ai][bj][m][n], 0, 0, 0); __builtin_amdgcn_s_setprio(0); } while (0)
#define PG8_WAIT_V(n) asm volatile("s_waitcnt vmcnt(" #n ")" ::: "memory")
#define PG8_WAIT_L(n) asm volatile("s_waitcnt lgkmcnt(" #n ")" ::: "memory")
#define PG8_BAR __builtin_amdgcn_s_barrier()
#define PG8_SCHED __builtin_amdgcn_sched_barrier(0)
    Unit cur, nxt; int ui = 0;
    if (!S.next(0, cur)) return;
    f32x4 acc[2][2][4][2];
#pragma unroll
    for (int a = 0; a < 2; ++a)
#pragma unroll
        for (int b = 0; b < 2; ++b)
#pragma unroll
            for (int m = 0; m < 4; ++m)
#pragma unroll
                for (int n = 0; n < 2; ++n) acc[a][b][m][n] = (f32x4){0.f, 0.f, 0.f, 0.f};
    bf16x8 At[4][2], B0[2][2], B1[2][2];
    const char* cA = (const char*)g.A + (size_t)cur.pm * tstep + (size_t)cur.kt0 * kstep; const char* cB = (const char*)g.Bt + (size_t)cur.pn * tstep + (size_t)cur.kt0 * kstep;
    S.a_ready(cur);
    if constexpr (SP2) {
        PG8_STAGE(PG8_SB(0, 0), cB, voffB); PG8_STAGE(PG8_SB(0, 1), cB + hstep, voffB); PG8_STAGE(PG8_SA(0, 0), cA, voffA); PG8_STAGE(PG8_SA(0, 1), cA + hstep, voffA);
        if (wr == 1) PG8_BAR;
        PG8_WAIT_V(2); PG8_BAR;
        PG8_STAGE(PG8_SB(1, 0), cB + kstep, voffB); PG8_STAGE(PG8_SA(1, 0), cA + kstep, voffA); PG8_STAGE(PG8_SB(1, 1), cB + hstep + kstep, voffB);
        PG8_WAIT_V(6); PG8_BAR;
    } else {
        PG8_STAGE(PG8_SB(0, 0), cB, voffB); PG8_STAGE(PG8_SA(0, 0), cA, voffA); PG8_STAGE(PG8_SB(0, 1), cB + hstep, voffB); PG8_STAGE(PG8_SA(0, 1), cA + hstep, voffA);
        if (wr == 1) PG8_BAR;
        PG8_WAIT_V(4); PG8_BAR;
        PG8_STAGE(PG8_SB(1, 0), cB + kstep, voffB); PG8_STAGE(PG8_SA(1, 0), cA + kstep, voffA); PG8_STAGE(PG8_SB(1, 1), cB + hstep + kstep, voffB);
        PG8_WAIT_V(6); PG8_BAR;
    }
    for (;;) {
        const bool has_next = S.next(ui + 1, nxt);
        const char* nA = has_next ? (const char*)g.A + (size_t)nxt.pm * tstep + (size_t)nxt.kt0 * kstep : cA; const char* nB = has_next ? (const char*)g.Bt + (size_t)nxt.pn * tstep + (size_t)nxt.kt0 * kstep : cB;
        const int nt = cur.nkt;
        for (int t = 0; t < nt; t += 2) {
            const bool last = (t == nt - 2);
            const char* a1 = cA + (size_t)(t + 1) * kstep;
            const char* a2 = last ? nA : cA + (size_t)(t + 2) * kstep; const char* b2 = last ? nB : cB + (size_t)(t + 2) * kstep;
            const char* a3 = a2 + kstep; const char* b3 = b2 + kstep;
            if (last && has_next) S.a_ready(nxt);
            if constexpr (SP2) {
            PG8_LDB(B0, 0, 0); PG8_LDB(B1, 0, 1); PG8_SCHED; PG8_LDA(At, 0, 0); PG8_STAGE(PG8_SA(1, 1), a1 + hstep, voffA);
            PG8_WAIT_V(8); PG8_WAIT_L(0); PG8_BAR; PG8_MMA(0, 0, At, B0); PG8_MMA(0, 1, At, B1); PG8_BAR; PG8_SCHED;
            PG8_LDA(At, 0, 1); PG8_STAGE(PG8_SB(0, 0), b2, voffB); PG8_STAGE(PG8_SB(0, 1), b2 + hstep, voffB); PG8_STAGE(PG8_SA(0, 0), a2, voffA);
            PG8_WAIT_V(8); PG8_WAIT_L(0); PG8_BAR; PG8_MMA(1, 0, At, B0); PG8_MMA(1, 1, At, B1); PG8_BAR; PG8_SCHED;
            PG8_LDB(B0, 1, 0); PG8_LDB(B1, 1, 1); PG8_SCHED; PG8_LDA(At, 1, 0); PG8_STAGE(PG8_SA(0, 1), a2 + hstep, voffA);
            PG8_WAIT_V(8); PG8_WAIT_L(0); PG8_BAR; PG8_MMA(0, 0, At, B0); PG8_MMA(0, 1, At, B1); PG8_BAR; PG8_SCHED;
            PG8_LDA(At, 1, 1); PG8_STAGE(PG8_SB(1, 0), b3, voffB); PG8_STAGE(PG8_SB(1, 1), b3 + hstep, voffB); PG8_STAGE(PG8_SA(1, 0), a3, voffA);
            PG8_WAIT_V(8); PG8_WAIT_L(0); PG8_BAR; PG8_MMA(1, 0, At, B0); PG8_MMA(1, 1, At, B1); PG8_BAR; PG8_SCHED;
            } else {
            PG8_LDB(B0, 0, 0); PG8_SCHED; PG8_LDA(At, 0, 0); PG8_STAGE(PG8_SA(1, 1), a1 + hstep, voffA);
            PG8_WAIT_L(8); PG8_BAR; PG8_WAIT_L(0); PG8_MMA(0, 0, At, B0); PG8_BAR; PG8_SCHED;
            PG8_LDB(B1, 0, 1); PG8_STAGE(PG8_SB(0, 0), b2, voffB);
            PG8_BAR; PG8_WAIT_L(0); PG8_MMA(0, 1, At, B1); PG8_BAR;
            PG8_LDA(At, 0, 1); PG8_STAGE(PG8_SA(0, 0), a2, voffA);
            PG8_BAR; PG8_WAIT_L(0); PG8_MMA(1, 0, At, B0); PG8_BAR; PG8_SCHED;
            PG8_STAGE(PG8_SB(0, 1), b2 + hstep, voffB);
            PG8_WAIT_V(6); PG8_BAR; PG8_MMA(1, 1, At, B1); PG8_BAR;
            PG8_LDB(B0, 1, 0); PG8_SCHED; PG8_LDA(At, 1, 0); PG8_STAGE(PG8_SA(0, 1), a2 + hstep, voffA);
            PG8_WAIT_L(8); PG8_BAR; PG8_WAIT_L(0); PG8_MMA(0, 0, At, B0); PG8_BAR; PG8_SCHED;
            PG8_LDB(B1, 1, 1); PG8_STAGE(PG8_SB(1, 0), b3, voffB);
            PG8_BAR; PG8_WAIT_L(0); PG8_MMA(0, 1, At, B1); PG8_BAR;
            PG8_LDA(At, 1, 1); PG8_STAGE(PG8_SA(1, 0), a3, voffA);
            PG8_BAR; PG8_WAIT_L(0); PG8_MMA(1, 0, At, B0); PG8_BAR; PG8_SCHED;
            PG8_STAGE(PG8_SB(1, 1), b3 + hstep, voffB);
            PG8_WAIT_V(6); PG8_BAR; PG8_MMA(1, 1, At, B1); PG8_BAR;
            }
        }
        if constexpr (ALIGN_EPI) { if (wr == 0) PG8_BAR; }
        if constexpr (!Epi::AFTER_DRAIN) { E(acc, cur, wr, wc, fr, fq); S.done(cur); }
        if (!has_next) break;
#pragma unroll
        for (int a = 0; a < 2; ++a)
#pragma unroll
            for (int b = 0; b < 2; ++b)
#pragma unroll
                for (int m = 0; m < 4; ++m)
#pragma unroll
                    for (int n = 0; n < 2; ++n) acc[a][b][m][n] = (f32x4){0.f, 0.f, 0.f, 0.f};
        cur = nxt; cA = nA; cB = nB; ++ui;
        if constexpr (ALIGN_EPI) { if (wr == 1) PG8_BAR; }
    }
    PG8_WAIT_V(0);
    if constexpr (!ALIGN_EPI) { if (wr == 0) PG8_BAR; }
    PG8_BAR;
    if constexpr (Epi::AFTER_DRAIN) { E.fused(acc, cur, wr, wc, fr, fq, lds, wid, lane); S.done(cur); }
#undef PG8_SA
#undef PG8_SB
#undef PG8_STAGE
#undef PG8_LDA
#undef PG8_LDB
#undef PG8_MMA
#undef PG8_WAIT_V
#undef PG8_WAIT_L
#undef PG8_BAR
#undef PG8_SCHED
}
}

constexpr int NWAVES = 8;
constexpr int D = 1024, NB = 8, SEQ = 4096, CTXL = 256, FF = 4096, NH = 8, DQK = 64, DV = 128;
constexpr int MX = NB * SEQ, MC = NB * CTXL, MT = MX + MC;
constexpr int NQKVO = 3328;
constexpr float EPS = 1e-6f;
#ifndef N_LAUNCHES
#define N_LAUNCHES 1
#endif
constexpr int N_PHASES = 17;
#ifndef PROBE
#define PROBE 0
#endif

constexpr size_t MiB = 1u << 20;
constexpr size_t WS_CTL = 0, CTL_ZERO_BYTES = 2 * MiB;
constexpr size_t WS_SS = 1 * MiB;
constexpr size_t WS_MOD = 2 * MiB;
constexpr size_t WS_WIN = 4 * MiB, WS_WOUT0 = 10 * MiB, WS_W1A = 12 * MiB, WS_W1B = 20 * MiB, WS_W2A = 28 * MiB, WS_W2B = 36 * MiB, WS_WQKVO = 44 * MiB, WS_WOUT1 = 52 * MiB;
constexpr size_t WS_H = 56 * MiB;
constexpr size_t WS_Y = 124 * MiB;
constexpr size_t WS_RC = 192 * MiB;
constexpr size_t WS_BIG = 200 * MiB;
constexpr size_t WS_Q = WS_BIG, WS_K = WS_Q + 32 * MiB, WS_V = WS_K + 34 * MiB, WS_O = WS_V + 68 * MiB, WS_GP = WS_O + 64 * MiB, WS_HB = WS_GP + 5 * MiB;
constexpr size_t WS_GREC = WS_BIG + 272 * MiB;
constexpr size_t WS_SLAB = WS_GREC;
constexpr size_t WS_END = WS_GREC + 40 * MiB;
static_assert(WS_HB + 64 * MiB <= WS_END, "scan tensors fit");
constexpr int CW_TMO = 0, CW_BAR = 4096;

constexpr int RING_OFF = 0, RING_BYTES = 131072;
constexpr int LDSCTL_OFF = RING_BYTES, MISC_OFF = LDSCTL_OFF + 320;
constexpr int LDS_BYTES = 147456;

#define GAS __attribute__((address_space(1)))
#define LAS __attribute__((address_space(3)))
typedef unsigned short bf16;
typedef unsigned v4u __attribute__((ext_vector_type(4)));
typedef unsigned v2u __attribute__((ext_vector_type(2)));
typedef float f32x4 __attribute__((ext_vector_type(4)));
typedef GAS unsigned gu32;
#define RLX_AGENT __ATOMIC_RELAXED, __HIP_MEMORY_SCOPE_AGENT
#define LDS_WAIT() asm volatile("s_waitcnt lgkmcnt(0)" ::: "memory")
__device__ __forceinline__ unsigned f2bf(float f) { unsigned u = __builtin_bit_cast(unsigned, f); return (u + 0x7fffu + ((u >> 16) & 1u)) >> 16; }
__device__ __forceinline__ unsigned pk2(float lo, float hi) { return f2bf(lo) | (f2bf(hi) << 16); }
__device__ __forceinline__ float bflo(unsigned w) { return __builtin_bit_cast(float, w << 16); }
__device__ __forceinline__ float bfhi(unsigned w) { return __builtin_bit_cast(float, w & 0xffff0000u); }
__device__ __forceinline__ float bf2f(bf16 b) { return __builtin_bit_cast(float, (unsigned)b << 16); }

#define XB_TMO      128
#define XB_XCNT(j)  (256  + 64 * (j))
#define XB_XSUB(j)  (1280 + 64 * (j))
#define XB_XGEN(j)  (2304 + 64 * (j))
#define XB_TOP      3328
#define XB_TOPGEN   3392
#define XCD_BAR_WORDS 3456
#define XB_SPIN_CAP (1u << 18)

__device__ __forceinline__ unsigned xb_ld(unsigned* p)              { return __hip_atomic_load(p, __ATOMIC_RELAXED, __HIP_MEMORY_SCOPE_AGENT); }
__device__ __forceinline__ unsigned xb_add(unsigned* p, unsigned v) { return __hip_atomic_fetch_add(p, v, __ATOMIC_RELAXED, __HIP_MEMORY_SCOPE_AGENT); }
__device__ __forceinline__ unsigned xb_xcc_id() { return (unsigned)__builtin_amdgcn_s_getreg((3 << 11) | 20) & 0xFu; }
#define XB_SPIN(cond, bar) do { unsigned _sp = 0; while (cond) { __builtin_amdgcn_s_sleep(1); \
    if ((++_sp & 255u) == 0u) { if (xb_ld(&(bar)[XB_TMO])) break; if (_sp > XB_SPIN_CAP) { atomicAdd(&(bar)[XB_TMO], 1u); break; } } } } while (0)

struct XcdBarrier {
    unsigned* bar; unsigned x;
    volatile LAS unsigned* st;
};

__device__ __forceinline__ XcdBarrier xcd_barrier_post(unsigned* bar, volatile LAS unsigned* st) {
    XcdBarrier b; b.bar = bar; b.x = xb_xcc_id(); b.st = st;
    if (threadIdx.x == 0) (void)xb_add(&bar[XB_XCNT(b.x)], 1u);
    return b;
}
__device__ __forceinline__ void xcd_barrier_complete(unsigned* bar, unsigned x, unsigned& nloc, unsigned& nx) {
    const unsigned G = gridDim.x * gridDim.y * gridDim.z;
    unsigned sum, cnt, mine, sp = 0u;
    for (;;) {
        sum = 0u; cnt = 0u; mine = 0u;
#pragma unroll
        for (unsigned j = 0; j < 16; ++j) { const unsigned c = xb_ld(&bar[XB_XCNT(j)]); sum += c; cnt += (c > 0u) ? 1u : 0u; mine = (j == x) ? c : mine; }
        if (sum == G) break;
        __builtin_amdgcn_s_sleep(1);
        if ((++sp & 255u) == 0u) { if (xb_ld(&bar[XB_TMO])) break; if (sp > XB_SPIN_CAP) { atomicAdd(&bar[XB_TMO], 1u); break; } }
    }
    nloc = mine > 0u ? mine : 1u; nx = cnt > 0u ? cnt : 1u;
}

__device__ __forceinline__ void xcd_barrier(const XcdBarrier& b) {
    asm volatile("s_waitcnt vmcnt(0)" ::: "memory");
    __syncthreads();
    if (threadIdx.x == 0) {
        unsigned* bar = b.bar;
        __builtin_amdgcn_s_waitcnt(0);
        unsigned nloc = b.st[0], nx = b.st[1];
        if (nloc == 0u) { xcd_barrier_complete(bar, b.x, nloc, nx); b.st[0] = nloc; b.st[1] = nx; }
        const unsigned old = xb_add(&bar[XB_XSUB(b.x)], 1u);
        const unsigned gen = old / nloc;
        if (old + 1u == (gen + 1u) * nloc) {
            __builtin_amdgcn_fence(__ATOMIC_RELEASE, "agent");
            asm volatile("s_waitcnt vmcnt(0)" ::: "memory");
            const unsigned og = xb_add(&bar[XB_TOP], 1u);
            const unsigned tg = og / nx;
            if (og + 1u == (tg + 1u) * nx) xb_add(&bar[XB_TOPGEN], 1u);
            else XB_SPIN(xb_ld(&bar[XB_TOPGEN]) == tg, bar);
            __builtin_amdgcn_fence(__ATOMIC_ACQUIRE, "agent");
            xb_add(&bar[XB_XGEN(b.x)], 1u);
            asm volatile("s_waitcnt vmcnt(0)" ::: "memory");
        } else {
            XB_SPIN(xb_ld(&bar[XB_XGEN(b.x)]) == gen, bar);
            __builtin_amdgcn_fence(__ATOMIC_ACQUIRE, "agent");
            asm volatile("s_waitcnt vmcnt(0)" ::: "memory");
        }
    }
    __syncthreads();
}


struct Frame {
    LAS unsigned char* lds;
    volatile LAS unsigned* MISC;
    gu32* ctl;
    int tid, lane, wave, vcu, G;
    const float *x, *c, *ctx, *cctx, *norm_w, *mod_w, *mod_b, *mlp_w1, *mlp_w2, *conv_w_in, *conv_w, *conv_w_out, *ml_w_qkvo, *ml_w_if, *ml_b_if, *ml_norm_w, *ml_w_out;
    float* out; unsigned char* ws;
};
__device__ __forceinline__ float wave_sum(float v) {
#pragma unroll
    for (int o = 1; o < 64; o <<= 1) v += __shfl_xor(v, o);
    return v;
}
__device__ __forceinline__ int convin_row(int n0) { if (n0 < 1024) return 2048 + n0; const int u = n0 >= 2048, ch = n0 - (u ? 2048 : 1024); return 256 * (ch >> 7) + 128 * u + (ch & 127); }
__device__ __forceinline__ void p0_transpose_item(const float* W, int K, int N, bf16* WT, int row_off, LAS float* scr, int item, int lane, bool convin = false) {
    const int nblk = N / 32, kb = item / nblk, nb = item % nblk, k0 = 64 * kb, n0 = 32 * nb; if (convin) row_off = convin_row(n0) - n0;
#pragma unroll 8
    for (int i = 0; i < 32; ++i) { const int kk = 2 * i + (lane >> 5); scr[kk * 33 + (lane & 31)] = W[(size_t)(k0 + kk) * N + n0 + (lane & 31)]; }
    LDS_WAIT(); asm volatile("" ::: "memory");
    const int c = lane & 7;
#pragma unroll
    for (int j = 0; j < 4; ++j) { const int n = (lane >> 3) + 8 * j; const LAS float* s = scr + (8 * c) * 33 + n;
        v4u o; o.x = pk2(s[0 * 33], s[1 * 33]); o.y = pk2(s[2 * 33], s[3 * 33]); o.z = pk2(s[4 * 33], s[5 * 33]); o.w = pk2(s[6 * 33], s[7 * 33]);
        *(v4u*)(WT + (size_t)(row_off + n0 + n) * K + k0 + 8 * c) = o; }
    LDS_WAIT(); asm volatile("" ::: "memory");
}

__device__ __forceinline__ void p0_prologue(Frame& F) {
    LAS float* sv = (LAS float*)(F.lds);
    LAS float* part = (LAS float*)(F.lds + 9 * 1024 * 4);
    for (int i = F.tid; i < 9 * 1024; i += NWAVES * 64) { const int bb = i >> 10, k = i & 1023; const float cv = bb < 8 ? F.c[bb * 1024 + k] : F.cctx[k]; sv[i] = cv / (1.f + expf(-cv)); }
    __syncthreads();
    float* MOD = (float*)(F.ws + WS_MOD);
    for (int item = F.vcu; item < 192; item += F.G) {
        const int layer = item / 96, jg = item % 96;
        const float* W = F.mod_w + (size_t)layer * 1024 * 6144 + jg * 64 + F.lane;
        const int k0 = F.wave * 128;
        float a0 = 0.f, a1 = 0.f, a2 = 0.f, a3 = 0.f, a4 = 0.f, a5 = 0.f, a6 = 0.f, a7 = 0.f, a8 = 0.f;
#pragma unroll 8
        for (int k = 0; k < 128; ++k) { const float w = W[(size_t)(k0 + k) * 6144]; const LAS float* s = sv + k0 + k;
            a0 += s[0] * w; a1 += s[1024] * w; a2 += s[2048] * w; a3 += s[3072] * w; a4 += s[4096] * w; a5 += s[5120] * w; a6 += s[6144] * w; a7 += s[7168] * w; a8 += s[8192] * w; }
        LAS float* pw = part + F.wave * 9 * 64 + F.lane;
        pw[0] = a0; pw[64] = a1; pw[128] = a2; pw[192] = a3; pw[256] = a4; pw[320] = a5; pw[384] = a6; pw[448] = a7; pw[512] = a8;
        __syncthreads();
        for (int o = F.tid; o < 9 * 64; o += NWAVES * 64) { const int bb = o >> 6, col = o & 63; float s = F.mod_b[layer * 6144 + jg * 64 + col];
#pragma unroll
            for (int w = 0; w < 8; ++w) s += part[(w * 9 + bb) * 64 + col];
            MOD[(size_t)(layer * 9 + bb) * 6144 + jg * 64 + col] = s; }
        __syncthreads();
    }
    __syncthreads();
    LAS float* scr = (LAS float*)(F.lds + RING_OFF + F.wave * 16384);
    const int gw = F.vcu * NWAVES + F.wave, NGW = F.G * NWAVES;
    constexpr int I_IN = 16 * 96, I_O = 16 * 32, I_1 = 16 * 128, I_2 = 64 * 32;
    constexpr int NITEMS = 2 * I_IN + 2 * I_O + 2 * I_1 + 2 * I_2;
    for (int it = gw; it < NITEMS; it += NGW) {
        int r = it;
        if (r < I_IN) { p0_transpose_item(F.conv_w_in, D, 3072, (bf16*)(F.ws + WS_WIN), 0, scr, r, F.lane, true); continue; } r -= I_IN;
        if (r < I_IN) { p0_transpose_item(F.ml_w_qkvo, D, 3072, (bf16*)(F.ws + WS_WQKVO), 0, scr, r, F.lane); continue; } r -= I_IN;
        if (r < I_O) { p0_transpose_item(F.conv_w_out, D, D, (bf16*)(F.ws + WS_WOUT0), 0, scr, r, F.lane); continue; } r -= I_O;
        if (r < I_O) { p0_transpose_item(F.ml_w_out, D, D, (bf16*)(F.ws + WS_WOUT1), 0, scr, r, F.lane); continue; } r -= I_O;
        if (r < I_1) { p0_transpose_item(F.mlp_w1, D, FF, (bf16*)(F.ws + WS_W1A), 0, scr, r, F.lane); continue; } r -= I_1;
        if (r < I_1) { p0_transpose_item(F.mlp_w1 + (size_t)D * FF, D, FF, (bf16*)(F.ws + WS_W1B), 0, scr, r, F.lane); continue; } r -= I_1;
        if (r < I_2) { p0_transpose_item(F.mlp_w2, FF, D, (bf16*)(F.ws + WS_W2A), 0, scr, r, F.lane); continue; } r -= I_2;
        p0_transpose_item(F.mlp_w2 + (size_t)D * FF, FF, D, (bf16*)(F.ws + WS_W2B), 0, scr, r, F.lane);
    }
    bf16* WG = (bf16*)(F.ws + WS_WQKVO) + (size_t)3072 * 1024;
    for (int i = gw * 64 + F.lane; i < 256 * 1024; i += NGW * 64) { const int j = i >> 10, k = i & 1023;
        WG[i] = j < 32 ? (bf16)f2bf(F.ml_w_if[(size_t)(j >> 4) * 1024 * 16 + k * 16 + (j & 15)]) : (bf16)0; }
}

struct Row { f32x4 v[4]; };
__device__ __forceinline__ Row ld_f32(const float* p, int lane) { Row r; const f32x4* q = (const f32x4*)p + lane;
#pragma unroll
    for (int j = 0; j < 4; ++j) r.v[j] = q[64 * j]; return r; }
__device__ __forceinline__ Row ld_bf16(const bf16* p, int lane) { Row r; const v2u* q = (const v2u*)p + lane;
#pragma unroll
    for (int j = 0; j < 4; ++j) { const v2u w = q[64 * j]; r.v[j] = (f32x4){bflo(w.x), bfhi(w.x), bflo(w.y), bfhi(w.y)}; } return r; }
__device__ __forceinline__ void st_f32(float* p, int lane, const Row& r) { f32x4* q = (f32x4*)p + lane;
#pragma unroll
    for (int j = 0; j < 4; ++j) q[64 * j] = r.v[j]; }
__device__ __forceinline__ void st_bf16(bf16* p, int lane, const Row& r) { v2u* q = (v2u*)p + lane;
#pragma unroll
    for (int j = 0; j < 4; ++j) { v2u w; w.x = pk2(r.v[j][0], r.v[j][1]); w.y = pk2(r.v[j][2], r.v[j][3]); q[64 * j] = w; } }
__device__ __forceinline__ float row_ss(const Row& r) { float s = 0.f;
#pragma unroll
    for (int j = 0; j < 4; ++j) s += (r.v[j][0] * r.v[j][0] + r.v[j][1] * r.v[j][1]) + (r.v[j][2] * r.v[j][2] + r.v[j][3] * r.v[j][3]);
    return wave_sum(s); }
struct NormMod { Row wsc, sh; };
__device__ __forceinline__ NormMod mk_normmod(const float* nw, const float* shift, const float* scale, int lane) { NormMod n; const Row w = ld_f32(nw, lane), sc = ld_f32(scale, lane); n.sh = ld_f32(shift, lane);
#pragma unroll
    for (int j = 0; j < 4; ++j) n.wsc.v[j] = w.v[j] * (sc.v[j] + 1.f); return n; }
__device__ __forceinline__ Row norm_mod(const Row& x, const NormMod& n) {
    const float rstd = 1.f / sqrtf(row_ss(x) * (1.f / D) + EPS); Row h;
#pragma unroll
    for (int j = 0; j < 4; ++j) h.v[j] = (x.v[j] * rstd * n.wsc.v[j]) + n.sh.v[j];
    return h; }
__device__ __forceinline__ Row mk_gw(const float* nw, const float* gate, int lane) { const Row w = ld_f32(nw, lane), g = ld_f32(gate, lane); Row o;
#pragma unroll
    for (int j = 0; j < 4; ++j) o.v[j] = w.v[j] * g.v[j]; return o; }
__device__ __forceinline__ Row resid(const Row& x, const Row& y, float ssy, const Row& gw) {
    const float rstd = 1.f / sqrtf(ssy * (1.f / D) + EPS); Row o;
#pragma unroll
    for (int j = 0; j < 4; ++j) o.v[j] = x.v[j] + (y.v[j] * rstd) * gw.v[j];
    return o; }
__device__ __forceinline__ const float* row_in(const Frame& F, int m) { return m < MX ? F.x + (size_t)m * D : F.ctx + (size_t)(m - MX) * D; }
__device__ __forceinline__ float* row_res(const Frame& F, int m) { return m < MX ? F.out + (size_t)m * D : (float*)(F.ws + WS_RC) + (size_t)(m - MX) * D; }
__device__ __forceinline__ bf16* r16a(const Frame& F, int m) { return (bf16*)((unsigned char*)F.out + (size_t)64 * MiB) + (size_t)m * D; }
__device__ __forceinline__ bf16* r16t(const Frame& F, int m) { return m < 28672 ? (bf16*)(F.ws + (size_t)456 * MiB) + (size_t)m * D : (bf16*)(F.ws + WS_RC) + (size_t)(m - 28672) * D; }
__device__ __forceinline__ int batch_of(int m) { return m < MX ? (m >> 12) : 8; }
__device__ __forceinline__ const float* modb(const Frame& F, int layer, int bb, int which) { return (const float*)(F.ws + WS_MOD) + (size_t)(layer * 9 + bb) * 6144 + which * 1024; }
#define ROWBLOCK(nrows) const int gwv_ = F.vcu * NWAVES + F.wave, NGW = F.G * NWAVES, per = ((nrows) + NGW - 1) / NGW, m_lo = gwv_ * per, m_hi = (m_lo + per) < (nrows) ? (m_lo + per) : (nrows)

template <int N> __device__ __forceinline__ void px1_rows(Frame& F, int m, const NormMod& nm, bf16* H) {
    Row x[N];
#pragma unroll
    for (int i = 0; i < N; ++i) x[i] = ld_f32(row_in(F, m + i), F.lane);
#pragma unroll
    for (int i = 0; i < N; ++i) st_bf16(H + (size_t)(m + i) * D, F.lane, norm_mod(x[i], nm));
}
__device__ __forceinline__ void px1(Frame& F) {
    ROWBLOCK(MT); bf16* H = (bf16*)(F.ws + WS_H); int bbc = -1; NormMod nm;
    for (int m = m_lo; m < m_hi;) { const int bb = batch_of(m);
        if (bb != bbc) { nm = mk_normmod(F.norm_w, modb(F, 0, bb, 0), modb(F, 0, bb, 1), F.lane); bbc = bb; }
        if (m + 1 < m_hi && batch_of(m + 1) == bb) { px1_rows<2>(F, m, nm, H); m += 2; } else { px1_rows<1>(F, m, nm, H); m += 1; } }
}
__device__ __forceinline__ void px2(Frame& F) {
    const int gw = F.vcu * NWAVES + F.wave, NGW = F.G * NWAVES; const bf16* P = (const bf16*)(F.ws + WS_BIG); bf16* Z = (bf16*)(F.ws + WS_H);
    const Row w0 = ld_f32(F.conv_w, F.lane), w1 = ld_f32(F.conv_w + 1024, F.lane), w2 = ld_f32(F.conv_w + 2048, F.lane);
    for (int seg = gw; seg < MT / 8; seg += NGW) {
        const int m0 = seg * 8; const int period = m0 < MX ? 64 : 256; const int t0 = (m0 < MX ? m0 : m0 - MX) % period;
        Row up, uc, un;
#pragma unroll
        for (int j = 0; j < 4; ++j) up.v[j] = (f32x4){0.f, 0.f, 0.f, 0.f};
        if (t0 > 0) up = ld_bf16(P + (size_t)(m0 - 1) * 2048, F.lane);
        uc = ld_bf16(P + (size_t)m0 * 2048, F.lane);
#pragma unroll 2
        for (int i = 0; i < 8; ++i) { const int m = m0 + i;
            if (t0 + i + 1 < period) un = ld_bf16(P + (size_t)(m + 1) * 2048, F.lane);
            else {
#pragma unroll
                for (int j = 0; j < 4; ++j) un.v[j] = (f32x4){0.f, 0.f, 0.f, 0.f}; }
            const Row bg = ld_bf16(P + (size_t)m * 2048 + 1024, F.lane); Row z;
#pragma unroll
            for (int j = 0; j < 4; ++j) z.v[j] = bg.v[j] * (w0.v[j] * up.v[j] + w1.v[j] * uc.v[j] + w2.v[j] * un.v[j]);
            st_bf16(Z + (size_t)m * D, F.lane, z); up = uc; uc = un; }
    }
}
template <int N> __device__ __forceinline__ void px3_rows(Frame& F, int layer, int m, const float* SS, const Row& gw, const NormMod& nm, bf16* H, const bf16* Y) {
    Row x[N], y[N]; float ss[N];
#pragma unroll
    for (int i = 0; i < N; ++i) { x[i] = layer == 0 ? ld_f32(row_in(F, m + i), F.lane) : ld_bf16(r16a(F, m + i), F.lane); y[i] = ld_bf16(Y + (size_t)(m + i) * D, F.lane); ss[i] = SS[m + i]; }
#pragma unroll
    for (int i = 0; i < N; ++i) { const Row xr = resid(x[i], y[i], ss[i], gw); st_bf16(layer == 0 ? r16a(F, m + i) : r16t(F, m + i), F.lane, xr); st_bf16(H + (size_t)(m + i) * D, F.lane, norm_mod(xr, nm)); }
}
__device__ __forceinline__ void px3(Frame& F, int layer, int nrows, int ssi) {
    ROWBLOCK(nrows); bf16* H = (bf16*)(F.ws + WS_H); const bf16* Y = (const bf16*)(F.ws + WS_Y);
    const float* SS = (const float*)(F.ws + WS_SS) + (size_t)ssi * MT; const float* nw = F.norm_w + layer * 4096; int bbc = -1; Row gw; NormMod nm;
    for (int m = m_lo; m < m_hi;) { const int bb = batch_of(m);
        if (bb != bbc) { gw = mk_gw(nw + 1024, modb(F, layer, bb, 2), F.lane); nm = mk_normmod(nw + 2048, modb(F, layer, bb, 3), modb(F, layer, bb, 4), F.lane); bbc = bb; }
        if (m >= MX) {
            const bf16* SL = (const bf16*)(F.ws + WS_SLAB) + (size_t)(m - MX) * D; Row y = ld_bf16(SL, F.lane);
#pragma unroll
            for (int ks = 1; ks < 4; ++ks) { const Row p = ld_bf16(SL + (size_t)ks * MC * D, F.lane);
#pragma unroll
                for (int j = 0; j < 4; ++j) y.v[j] += p.v[j]; }
            const Row x = ld_f32(row_in(F, m), F.lane); const Row xr = resid(x, y, row_ss(y), gw); st_f32(row_res(F, m), F.lane, xr); st_bf16(H + (size_t)m * D, F.lane, norm_mod(xr, nm)); m += 1; continue; }
        if (m + 1 < m_hi && batch_of(m + 1) == bb) { px3_rows<2>(F, layer, m, SS, gw, nm, H, Y); m += 2; } else { px3_rows<1>(F, layer, m, SS, gw, nm, H, Y); m += 1; } }
}
template <int N> __device__ __forceinline__ void px4_rows(Frame& F, int m, const float* SS, const Row& gw, const NormMod& nm, bf16* H, const bf16* Y) {
    Row x[N], y[N]; float ss[N];
#pragma unroll
    for (int i = 0; i < N; ++i) { x[i] = ld_bf16(r16a(F, m + i), F.lane); y[i] = ld_bf16(Y + (size_t)(m + i) * D, F.lane); ss[i] = SS[m + i]; }
#pragma unroll
    for (int i = 0; i < N; ++i) { const Row xr = resid(x[i], y[i], ss[i], gw); st_bf16(r16a(F, m + i), F.lane, xr); st_bf16(H + (size_t)(m + i) * D, F.lane, norm_mod(xr, nm)); }
}
__device__ __forceinline__ void px4(Frame& F) {
    ROWBLOCK(MT); bf16* H = (bf16*)(F.ws + WS_H); const bf16* Y = (const bf16*)(F.ws + WS_Y);
    const float* SS = (const float*)(F.ws + WS_SS) + (size_t)1 * MT; int bbc = -1; Row gw; NormMod nm;
    for (int m = m_lo; m < m_hi;) { const int bb = batch_of(m);
        if (bb != bbc) { gw = mk_gw(F.norm_w + 3 * 1024, modb(F, 0, bb, 5), F.lane); nm = mk_normmod(F.norm_w + 4096, modb(F, 1, bb, 0), modb(F, 1, bb, 1), F.lane); bbc = bb; }
        if (m >= MX) {
            const bf16* SL = (const bf16*)(F.ws + WS_SLAB) + (size_t)(m - MX) * D; Row y = ld_bf16(SL, F.lane);
#pragma unroll
            for (int ks = 1; ks < 8; ++ks) { const Row p = ld_bf16(SL + (size_t)ks * MC * D, F.lane);
#pragma unroll
                for (int j = 0; j < 4; ++j) y.v[j] += p.v[j]; }
            const Row x = ld_f32(row_res(F, m), F.lane); const Row xr = resid(x, y, row_ss(y), gw); st_bf16(H + (size_t)m * D, F.lane, norm_mod(xr, nm)); m += 1; continue; }
        if (m + 1 < m_hi && batch_of(m + 1) == bb) { px4_rows<2>(F, m, SS, gw, nm, H, Y); m += 2; } else { px4_rows<1>(F, m, SS, gw, nm, H, Y); m += 1; } }
}
template <int N> __device__ __forceinline__ void px5_rows(Frame& F, int m, const Row& nw, bf16* H, const bf16* HF, const bf16* HB, const bf16* O) {
    Row a[N], b[N], o[N];
#pragma unroll
    for (int i = 0; i < N; ++i) { a[i] = ld_bf16(HF + (size_t)(m + i) * D, F.lane); b[i] = ld_bf16(HB + (size_t)(m + i) * D, F.lane); o[i] = ld_bf16(O + (size_t)(m + i) * D, F.lane); }
#pragma unroll
    for (int i = 0; i < N; ++i) { Row h;
#pragma unroll
        for (int j = 0; j < 4; ++j) { const f32x4 s = a[i].v[j] + b[i].v[j]; float q = (s[0] * s[0] + s[1] * s[1]) + (s[2] * s[2] + s[3] * s[3]);
            q += __shfl_xor(q, 1); q += __shfl_xor(q, 2); q += __shfl_xor(q, 4); q += __shfl_xor(q, 8); q += __shfl_xor(q, 16);
            const float rstd = 1.f / sqrtf(q * (1.f / DV) + EPS);
#pragma unroll
            for (int e = 0; e < 4; ++e) h.v[j][e] = (s[e] * rstd * nw.v[j][e]) / (1.f + __builtin_amdgcn_exp2f(-1.44269504f * o[i].v[j][e])); }
        st_bf16(H + (size_t)(m + i) * D, F.lane, h); }
}
__device__ __forceinline__ void px5(Frame& F) {
    ROWBLOCK(MX); bf16* H = (bf16*)(F.ws + WS_H);
    const bf16* HF = (const bf16*)(F.ws + WS_Y); const bf16* HB = (const bf16*)(F.ws + WS_HB); const bf16* O = (const bf16*)(F.ws + WS_O);
    const Row nw = ld_f32(F.ml_norm_w, F.lane);
    for (int m = m_lo; m < m_hi;) { if (m + 1 < m_hi) { px5_rows<2>(F, m, nw, H, HF, HB, O); m += 2; } else { px5_rows<1>(F, m, nw, H, HF, HB, O); m += 1; } }
}
template <int N> __device__ __forceinline__ void px7_rows(Frame& F, int m, const float* SS, const Row& gw, const bf16* Y) {
    Row x[N], y[N]; float ss[N];
#pragma unroll
    for (int i = 0; i < N; ++i) { x[i] = ld_bf16(r16t(F, m + i), F.lane); y[i] = ld_bf16(Y + (size_t)(m + i) * D, F.lane); ss[i] = SS[m + i]; }
#pragma unroll
    for (int i = 0; i < N; ++i) st_f32(F.out + (size_t)(m + i) * D, F.lane, resid(x[i], y[i], ss[i], gw));
}
__device__ __forceinline__ void px7(Frame& F) {
    ROWBLOCK(MX); const bf16* Y = (const bf16*)(F.ws + WS_Y);
    const float* SS = (const float*)(F.ws + WS_SS) + (size_t)3 * MT; int bbc = -1; Row gw;
    for (int m = m_lo; m < m_hi;) { const int bb = batch_of(m);
        if (bb != bbc) { gw = mk_gw(F.norm_w + 4096 + 3 * 1024, modb(F, 1, bb, 5), F.lane); bbc = bb; }
        if (m + 1 < m_hi && batch_of(m + 1) == bb) { px7_rows<2>(F, m, SS, gw, Y); m += 2; } else { px7_rows<1>(F, m, SS, gw, Y); m += 1; } }
}

__device__ __forceinline__ int scan_row(int b, int r, int p) {
    if (p < CTXL) return MX + b * CTXL + (r == 0 ? p : CTXL - 1 - p);
    const int q = p - CTXL; return b * SEQ + (r == 0 ? q : SEQ - 1 - q);
}
__device__ __forceinline__ void scan_naive(Frame& F) {
    LAS float* qs = (LAS float*)(F.lds);
    LAS float* ks = qs + 32 * 64;
    LAS float* vs = ks + 32 * 64;
    LAS float* gi = vs + 32 * 128;
    LAS float* gf = gi + 32;
    LAS float* part = gf + 32;
    LAS float* pden = part + 2 * 4 * 128;
    const bf16* Q = (const bf16*)(F.ws + WS_Q); const bf16* K = (const bf16*)(F.ws + WS_K); const bf16* V = (const bf16*)(F.ws + WS_V); const float* GP = (const float*)(F.ws + WS_GP);
    const int v = F.tid & 127, dq = F.tid >> 7;
    for (int seq = F.vcu; seq < NB * NH * 2; seq += F.G) {
        const int b = seq >> 4, h = (seq >> 1) & 7, r = seq & 1;
        bf16* OUT = (bf16*)(F.ws + (r == 0 ? WS_Y : WS_HB));
        const float bi = F.ml_b_if[r * 16 + h], bfg = F.ml_b_if[r * 16 + 8 + h];
        float C[16], n[16];
#pragma unroll
        for (int j = 0; j < 16; ++j) { C[j] = 0.f; n[j] = 0.f; }
        for (int p0 = 0; p0 < CTXL + SEQ; p0 += 32) {
            __syncthreads();
            for (int i = F.tid; i < 32 * 64; i += NWAVES * 64) { const int s = i >> 6, d = i & 63; const int row = scan_row(b, r, p0 + s);
                qs[i] = row < MX ? bf2f(Q[(size_t)row * 512 + h * 64 + d]) : 0.f; ks[i] = bf2f(K[(size_t)row * 512 + h * 64 + d]); }
            for (int i = F.tid; i < 32 * 128; i += NWAVES * 64) { const int s = i >> 7, vv = i & 127; const int row = scan_row(b, r, p0 + s); vs[i] = bf2f(V[(size_t)row * 1024 + h * 128 + vv]); }
            if (F.tid < 32) { const int row = scan_row(b, r, p0 + F.tid); const float ig = GP[(size_t)row * 32 + r * 16 + h] + bi, fg = GP[(size_t)row * 32 + r * 16 + 8 + h] + bfg;
                gi[F.tid] = expf(ig); gf[F.tid] = 1.f / (1.f + expf(-fg)); }
            __syncthreads();
            for (int s = 0; s < 32; ++s) {
                const float f = gf[s], ii = gi[s] * vs[s * 128 + v], i0 = gi[s]; float pn = 0.f, pd = 0.f;
#pragma unroll
                for (int j = 0; j < 16; ++j) { const float kd = ks[s * 64 + dq * 16 + j], qd = qs[s * 64 + dq * 16 + j];
                    C[j] = f * C[j] + ii * kd; n[j] = f * n[j] + i0 * kd; pn += qd * C[j]; pd += qd * n[j]; }
                part[((s & 1) * 4 + dq) * 128 + v] = pn; if (v == 0) pden[(s & 1) * 4 + dq] = pd;
                __syncthreads();
                if (F.tid < 128 && p0 + s >= CTXL) { const LAS float* pp = part + (s & 1) * 512 + F.tid; const LAS float* dd = pden + (s & 1) * 4;
                    const float num = (pp[0] + pp[128]) + (pp[256] + pp[384]), den = (dd[0] + dd[1]) + (dd[2] + dd[3]);
                    const int row = scan_row(b, r, p0 + s);
                    OUT[(size_t)row * 1024 + h * 128 + F.tid] = (bf16)f2bf(num / fmaxf(fabsf(den), 1.f)); }
            }
        }
    }
}

typedef short bf16x8 __attribute__((ext_vector_type(8)));
typedef short v4i16_t __attribute__((ext_vector_type(4)));
typedef float f32x2_t __attribute__((ext_vector_type(2)));
typedef __bf16 bf16x2_t __attribute__((ext_vector_type(2)));
__device__ __forceinline__ unsigned cvtpk(float lo, float hi) { f32x2_t v = {lo, hi}; bf16x2_t b = __builtin_convertvector(v, bf16x2_t); return __builtin_bit_cast(unsigned, b); }
__device__ __forceinline__ v4i16_t tr16(LAS unsigned char* p) { return __builtin_amdgcn_ds_read_tr16_b64_v4i16((LAS v4i16_t*)p); }
__device__ __forceinline__ bf16x8 mk8(v4i16_t lo, v4i16_t hi) { return (bf16x8){lo[0], lo[1], lo[2], lo[3], hi[0], hi[1], hi[2], hi[3]}; }
__device__ __forceinline__ float s2f(short s) { return __builtin_bit_cast(float, (unsigned)(unsigned short)s << 16); }
__device__ __forceinline__ float logsig(float g) { return fminf(g, 0.f) - log1pf(expf(-fabsf(g))); }
constexpr int SC_KR = 0, SC_KRB = 18432, SC_VR = 36864, SC_VRB = 20480, SC_CB = 77824, SC_CBB = 11520, SC_GT = 100864, SC_GTB = 2048;
constexpr int NCHUNK = (CTXL + SEQ) / 128;
static_assert(SC_GT + 2 * SC_GTB <= RING_BYTES, "scan LDS map");

template <int RB> __device__ __forceinline__ void scan_out(LAS unsigned char* kr, LAS unsigned char* vr, LAS unsigned char* cbr, LAS float* gt, const bf16x8 q0, const bf16x8 q1, const int l15, const int g, const int tro, const int trc, bf16* op) {
                const float btv = gt[16 * RB + l15]; const float ebt = __builtin_amdgcn_exp2f(btv);
                bf16x8 pf[4];
#pragma unroll
                for (int kk = 0; kk < 4; ++kk) {
                    f32x4 pv[2];
#pragma unroll
                    for (int e = 0; e < 2; ++e) { const int sb = 2 * kk + e; pv[e] = (f32x4){0.f, 0.f, 0.f, 0.f};
                        if (sb <= RB) {
                            f32x4 acc = (f32x4){0.f, 0.f, 0.f, 0.f};
                            acc = __builtin_amdgcn_mfma_f32_16x16x32_bf16(*(LAS bf16x8*)(kr + (16 * sb + l15) * 144 + (8 * g) * 2), q0, acc, 0, 0, 0);
                            acc = __builtin_amdgcn_mfma_f32_16x16x32_bf16(*(LAS bf16x8*)(kr + (16 * sb + l15) * 144 + (32 + 8 * g) * 2), q1, acc, 0, 0, 0);
                            const f32x4 ibv = *(LAS f32x4*)(gt + 128 + 16 * sb + 4 * g);
#pragma unroll
                            for (int reg = 0; reg < 4; ++reg) { float p = acc[reg] * __builtin_amdgcn_exp2f(btv + ibv[reg]);
                                if (sb == RB && 4 * g + reg > l15) p = 0.f; pv[e][reg] = p; }
                        } }
                    v4u pk; pk.x = cvtpk(pv[0][0], pv[0][1]); pk.y = cvtpk(pv[0][2], pv[0][3]); pk.z = cvtpk(pv[1][0], pv[1][1]); pk.w = cvtpk(pv[1][2], pv[1][3]);
                    pf[kk] = __builtin_bit_cast(bf16x8, pk);
                }
                f32x4 num[5];
#pragma unroll
                for (int vb = 0; vb < 5; ++vb) {
                    f32x4 oa = (f32x4){0.f, 0.f, 0.f, 0.f}, qa = (f32x4){0.f, 0.f, 0.f, 0.f};
#pragma unroll
                    for (int kk = 0; kk < 4; ++kk) if (2 * kk <= RB) {
                        const v4i16_t lo = tr16(vr + (32 * kk + tro) * 160 + (16 * vb + trc) * 2), hi = tr16(vr + (32 * kk + 16 + tro) * 160 + (16 * vb + trc) * 2);
                        oa = __builtin_amdgcn_mfma_f32_16x16x32_bf16(mk8(lo, hi), pf[kk], oa, 0, 0, 0); }
                    qa = __builtin_amdgcn_mfma_f32_16x16x32_bf16(*(LAS bf16x8*)(cbr + (16 * vb + l15) * 144 + (8 * g) * 2), q0, qa, 0, 0, 0);
                    qa = __builtin_amdgcn_mfma_f32_16x16x32_bf16(*(LAS bf16x8*)(cbr + (16 * vb + l15) * 144 + (32 + 8 * g) * 2), q1, qa, 0, 0, 0);
                    num[vb] = oa + qa * ebt;
                }
                const float den = __shfl(num[4][0], l15);
                const float sc = 1.f / fmaxf(fabsf(den), 1.f);
                #pragma unroll
                for (int vb = 0; vb < 4; ++vb) { v2u o; o.x = cvtpk(num[vb][0] * sc, num[vb][1] * sc); o.y = cvtpk(num[vb][2] * sc, num[vb][3] * sc); *(v2u*)(op + 16 * vb) = o; }

}
template <int RB> __device__ __forceinline__ void scan_update(LAS unsigned char* kr, LAS unsigned char* vr, LAS unsigned char* cbw, LAS float* gt, f32x4 (&cacc)[3], const int l15, const int g, const int tro, const int trc) {
    constexpr int W = RB < 4 ? RB : 11 - RB, nvb = W < 4 ? 3 : 2, vb0 = W < 4 ? 0 : 3, db = W & 3;
            const float a = gt[384];
#pragma unroll
            for (int i = 0; i < 3; ++i) cacc[i] = cacc[i] * a;
#pragma unroll
            for (int kk = 0; kk < 4; ++kk) {
                const v4i16_t klo = tr16(kr + (32 * kk + tro) * 144 + (16 * db + trc) * 2), khi = tr16(kr + (32 * kk + 16 + tro) * 144 + (16 * db + trc) * 2);
                const f32x4 wlo = *(LAS f32x4*)(gt + 256 + 32 * kk + 4 * g), whi = *(LAS f32x4*)(gt + 256 + 32 * kk + 16 + 4 * g);
                v4u pk; pk.x = cvtpk(s2f(klo[0]) * wlo[0], s2f(klo[1]) * wlo[1]); pk.y = cvtpk(s2f(klo[2]) * wlo[2], s2f(klo[3]) * wlo[3]);
                pk.z = cvtpk(s2f(khi[0]) * whi[0], s2f(khi[1]) * whi[1]); pk.w = cvtpk(s2f(khi[2]) * whi[2], s2f(khi[3]) * whi[3]);
                const bf16x8 bfrag = __builtin_bit_cast(bf16x8, pk);
#pragma unroll
                for (int i = 0; i < 3; ++i) if (i < nvb) { const int vb = vb0 + i;
                    const v4i16_t lo = tr16(vr + (32 * kk + tro) * 160 + (16 * vb + trc) * 2), hi = tr16(vr + (32 * kk + 16 + tro) * 160 + (16 * vb + trc) * 2);
                    cacc[i] = __builtin_amdgcn_mfma_f32_16x16x32_bf16(mk8(lo, hi), bfrag, cacc[i], 0, 0, 0); }
            }
#pragma unroll
            for (int i = 0; i < 3; ++i) if (i < nvb) { const int vb = vb0 + i;
#pragma unroll
                for (int reg = 0; reg < 4; ++reg) *(LAS bf16*)(cbw + (16 * vb + 4 * g + reg) * 144 + (16 * db + l15) * 2) = (bf16)(cvtpk(cacc[i][reg], 0.f) & 0xffffu); }
        }
__device__ __forceinline__ void scan_mfma(Frame& F) {
    const int lane = F.lane, w = F.wave, g = lane >> 4, l15 = lane & 15;
    LAS unsigned char* lds = F.lds;
    const bf16* Qg = (const bf16*)(F.ws + WS_Q); const bf16* Kg = (const bf16*)(F.ws + WS_K); const bf16* Vg = (const bf16*)(F.ws + WS_V); const float* GP = (const float*)(F.ws + WS_GP);
    const int rb = w < 4 ? w : 11 - w;
    const int tro = 4 * g + (l15 >> 2), trc = 4 * (l15 & 3);
    for (int unit = F.vcu; unit < 256; unit += F.G) {
        const int b = unit >> 5, h = (unit >> 2) & 7, r = (unit >> 1) & 1, vh = unit & 1;
        bf16* OUT = (bf16*)(F.ws + (r == 0 ? WS_Y : WS_HB));
        const float bi = F.ml_b_if[r * 16 + h], bfg = F.ml_b_if[r * 16 + 8 + h];
        __syncthreads();
        { const int bufi = F.tid >> 8, s = (F.tid >> 1) & 127, half = F.tid & 1;
          *(LAS v4u*)(lds + SC_VR + bufi * SC_VRB + s * 160 + 128 + half * 16) = half == 0 ? (v4u){0x00003F80u, 0u, 0u, 0u} : (v4u){0u, 0u, 0u, 0u}; }
        f32x4 cacc[3];
#pragma unroll
        for (int i = 0; i < 3; ++i) cacc[i] = (f32x4){0.f, 0.f, 0.f, 0.f};
        v4u kp[2], vp[2], grp = (v4u){0u, 0u, 0u, 0u}; bf16x8 qf[2];
        qf[0] = (bf16x8){0, 0, 0, 0, 0, 0, 0, 0}; qf[1] = qf[0];
        float* grec = (float*)(F.ws + WS_GREC) + (size_t)unit * NCHUNK * 388;
        for (int c = w; c < NCHUNK; c += NWAVES) {
            const size_t row0 = (size_t)scan_row(b, r, c * 128 + 2 * lane), row1 = (size_t)scan_row(b, r, c * 128 + 2 * lane + 1);
            const float lf0 = logsig(GP[row0 * 32 + r * 16 + 8 + h] + bfg), lf1 = logsig(GP[row1 * 32 + r * 16 + 8 + h] + bfg), i0 = GP[row0 * 32 + r * 16 + h] + bi, i1 = GP[row1 * 32 + r * 16 + h] + bi;
            float incl = lf0 + lf1;
#pragma unroll
            for (int o = 1; o < 64; o <<= 1) { const float t = __shfl_up(incl, o); if (lane >= o) incl += t; }
            const float b0 = incl - lf1, b1 = incl, blast = __shfl(incl, 63);
            float* gr = grec + (size_t)c * 388;
            *(f32x2_t*)(gr + 2 * lane) = (f32x2_t){b0 * 1.44269504f, b1 * 1.44269504f}; *(f32x2_t*)(gr + 128 + 2 * lane) = (f32x2_t){(i0 - b0) * 1.44269504f, (i1 - b1) * 1.44269504f};
            *(f32x2_t*)(gr + 256 + 2 * lane) = (f32x2_t){expf(blast - b0 + i0), expf(blast - b1 + i1)};
            if (lane == 0) gr[384] = expf(blast);
        }
        asm volatile("s_waitcnt vmcnt(0)" ::: "memory");
        __syncthreads();
#define SC_PREFETCH(c) do { const int p0_ = (c) * 128; \
            _Pragma("unroll") for (int i_ = 0; i_ < 2; ++i_) { const int idx_ = F.tid + 512 * i_, s_ = idx_ >> 3, part_ = idx_ & 7; const size_t row_ = (size_t)scan_row(b, r, p0_ + s_); \
                kp[i_] = *(const v4u*)(Kg + row_ * 512 + h * 64 + part_ * 8); vp[i_] = *(const v4u*)(Vg + row_ * 1024 + h * 128 + vh * 64 + part_ * 8); } \
            if ((c) >= 2) { const size_t row_ = (size_t)scan_row(b, r, p0_ + 16 * rb + l15); \
                qf[0] = *(const bf16x8*)(Qg + row_ * 512 + h * 64 + 8 * g); qf[1] = *(const bf16x8*)(Qg + row_ * 512 + h * 64 + 32 + 8 * g); } \
            if (F.tid < 97) grp = *(const v4u*)(grec + (size_t)(c) * 388 + 4 * F.tid); } while (0)
        SC_PREFETCH(0);
        for (int c = 0; c < NCHUNK; ++c) {
            LAS unsigned char* kr = lds + SC_KR + (c & 1) * SC_KRB; LAS unsigned char* vr = lds + SC_VR + (c & 1) * SC_VRB;
            LAS unsigned char* cbr = lds + SC_CB + (c & 1) * SC_CBB; LAS unsigned char* cbw = lds + SC_CB + ((c + 1) & 1) * SC_CBB;
            LAS float* gt = (LAS float*)(lds + SC_GT + (c & 1) * SC_GTB);
#pragma unroll
            for (int i = 0; i < 2; ++i) { const int idx = F.tid + 512 * i, s = idx >> 3, part = idx & 7;
                *(LAS v4u*)(kr + s * 144 + part * 16) = kp[i]; *(LAS v4u*)(vr + s * 160 + part * 16) = vp[i]; }
            const bf16x8 q0 = qf[0], q1 = qf[1];
            if (F.tid < 97) *(LAS v4u*)((LAS unsigned char*)gt + 16 * F.tid) = grp;
            if (c + 1 < NCHUNK) SC_PREFETCH(c + 1);
            __syncthreads();
            const size_t orow = (size_t)scan_row(b, r, c * 128 + 16 * rb + l15);
            if (c >= 2) {
                bf16* op = OUT + orow * 1024 + h * 128 + vh * 64 + 4 * g;
                switch (rb) {
                    case 0: scan_out<0>(kr, vr, cbr, gt, q0, q1, l15, g, tro, trc, op); break;
                    case 1: scan_out<1>(kr, vr, cbr, gt, q0, q1, l15, g, tro, trc, op); break;
                    case 2: scan_out<2>(kr, vr, cbr, gt, q0, q1, l15, g, tro, trc, op); break;
                    case 3: scan_out<3>(kr, vr, cbr, gt, q0, q1, l15, g, tro, trc, op); break;
                    case 4: scan_out<4>(kr, vr, cbr, gt, q0, q1, l15, g, tro, trc, op); break;
                    case 5: scan_out<5>(kr, vr, cbr, gt, q0, q1, l15, g, tro, trc, op); break;
                    case 6: scan_out<6>(kr, vr, cbr, gt, q0, q1, l15, g, tro, trc, op); break;
                    default: scan_out<7>(kr, vr, cbr, gt, q0, q1, l15, g, tro, trc, op); break;
                }
            }
            switch (rb) {
                case 0: scan_update<0>(kr, vr, cbw, gt, cacc, l15, g, tro, trc); break;
                case 1: scan_update<1>(kr, vr, cbw, gt, cacc, l15, g, tro, trc); break;
                case 2: scan_update<2>(kr, vr, cbw, gt, cacc, l15, g, tro, trc); break;
                case 3: scan_update<3>(kr, vr, cbw, gt, cacc, l15, g, tro, trc); break;
                case 4: scan_update<4>(kr, vr, cbw, gt, cacc, l15, g, tro, trc); break;
                case 5: scan_update<5>(kr, vr, cbw, gt, cacc, l15, g, tro, trc); break;
                case 6: scan_update<6>(kr, vr, cbw, gt, cacc, l15, g, tro, trc); break;
                default: scan_update<7>(kr, vr, cbw, gt, cacc, l15, g, tro, trc); break;
            }
        }
#undef SC_PREFETCH
    }
}

struct Args { const float* in[17]; float* out; unsigned char* ws; int ph_lo, ph_hi, li, pad; };
__global__ void __launch_bounds__(NWAVES * 64, 2) fwd_kernel(Args args) {
    extern __shared__ __attribute__((aligned(16))) unsigned char lds[];
    Frame F;
    F.lds = (LAS unsigned char*)lds;
    F.MISC = (volatile LAS unsigned*)(F.lds + MISC_OFF);
    F.tid = threadIdx.x; F.lane = F.tid & 63; F.wave = __builtin_amdgcn_readfirstlane(F.tid >> 6);
    F.G = gridDim.x; { const int bx = blockIdx.x; F.vcu = (F.G % 8 == 0) ? (bx % 8) * (F.G / 8) + bx / 8 : bx; }
    F.ws = args.ws; F.out = args.out; F.ctl = (gu32*)(args.ws + WS_CTL);
    F.x = args.in[0]; F.c = args.in[1]; F.ctx = args.in[2]; F.cctx = args.in[3]; F.norm_w = args.in[4]; F.mod_w = args.in[5]; F.mod_b = args.in[6]; F.mlp_w1 = args.in[7]; F.mlp_w2 = args.in[8];
    F.conv_w_in = args.in[9]; F.conv_w = args.in[10]; F.conv_w_out = args.in[11]; F.ml_w_qkvo = args.in[12]; F.ml_w_if = args.in[13]; F.ml_b_if = args.in[14]; F.ml_norm_w = args.in[15]; F.ml_w_out = args.in[16];
    for (int u = F.tid; u < (LDS_BYTES - LDSCTL_OFF) / 4; u += NWAVES * 64) ((LAS unsigned*)(F.lds + LDSCTL_OFF))[u] = 0u;
    __syncthreads();
    XcdBarrier bar; bar.bar = (unsigned*)(F.ctl + CW_BAR); bar.x = 0; bar.st = nullptr;
    if (N_LAUNCHES == 1) bar = xcd_barrier_post((unsigned*)(F.ctl + CW_BAR), F.MISC + 8);
    const int lo = args.ph_lo, hi = args.ph_hi;
#define IN(k) (lo <= (k) && (k) < hi)
#define SEAM(k) do { if (IN(k) && IN((k) + 1)) xcd_barrier(bar); } while (0)
    bf16* const H = (bf16*)(F.ws + WS_H); bf16* const Y = (bf16*)(F.ws + WS_Y); bf16* const BIG = (bf16*)(F.ws + WS_BIG); float* const SS = (float*)(F.ws + WS_SS);

    if (IN(0)) { p0_prologue(F); if (PROBE & 8) { xcd_barrier(bar); p0_prologue(F); } } SEAM(0);
    if (IN(1)) { px1(F); if (PROBE & 1) { xcd_barrier(bar); px1(F); } } SEAM(1);
    if (IN(2)) {
        pg8::Gemm g{H, (const bf16*)(F.ws + WS_WIN), MT, 3072, D}; pg8::StaticOrder S; S.init(MT, 3072, F.G, (int)blockIdx.x);
        pg8::EpiConvIn E{BIG};
        pg8::gemm_phase<pg8::EpiConvIn, pg8::StaticOrder, true, true>(F.lds + RING_OFF, g, S, E); } SEAM(2);
    if (IN(3)) { px2(F); if (PROBE & 1) { xcd_barrier(bar); px2(F); } } SEAM(3);
    if (IN(4)) {
        pg8::Gemm g{H, (const bf16*)(F.ws + WS_WOUT0), MT, D, D}; pg8::SplitOrder S; S.init(D, 4, F.G, (int)blockIdx.x);
        pg8::EpiBf16SS E{Y, D, SS, (bf16*)(F.ws + WS_SLAB), D / 64 / 4};
        pg8::gemm_phase<pg8::EpiBf16SS, pg8::SplitOrder, true, true>(F.lds + RING_OFF, g, S, E); } SEAM(4);
    if (IN(5)) { px3(F, 0, MT, 0); } SEAM(5);
    if (IN(6)) {
        pg8::Gemm g{H, (const bf16*)(F.ws + WS_W1A), MT, FF, D}; pg8::StaticOrder S; S.init(MT, FF, F.G, (int)blockIdx.x);
        pg8::EpiBf16<2> E{BIG, FF};
        pg8::gemm_phase<pg8::EpiBf16<2>, pg8::StaticOrder, true, true>(F.lds + RING_OFF, g, S, E); } SEAM(6);
    if (IN(7)) {
        pg8::Gemm g{BIG, (const bf16*)(F.ws + WS_W2A), MT, D, FF}; pg8::SplitOrder S; S.init(FF, 8, F.G, (int)blockIdx.x, 1);
        pg8::EpiBf16SS E{Y, D, SS + MT, (bf16*)(F.ws + WS_SLAB), FF / 64 / 8};
        pg8::gemm_phase<pg8::EpiBf16SS, pg8::SplitOrder, true, true>(F.lds + RING_OFF, g, S, E); } SEAM(7);
    if (IN(8)) { px4(F); } SEAM(8);
    if (IN(9)) {
        pg8::Gemm g{H, (const bf16*)(F.ws + WS_WQKVO), MT, NQKVO, D}; pg8::QkvoOrder S; S.init(F.G, (int)blockIdx.x);
        pg8::EpiQkvo E{(bf16*)(F.ws + WS_Q), (bf16*)(F.ws + WS_K), (bf16*)(F.ws + WS_V), (bf16*)(F.ws + WS_O), (float*)(F.ws + WS_GP)};
        pg8::gemm_phase<pg8::EpiQkvo, pg8::QkvoOrder, true, true>(F.lds + RING_OFF, g, S, E); } SEAM(9);
    #if defined(SCAN_NAIVE)
    if (IN(10)) { scan_naive(F); } SEAM(10);
#else
    if (IN(10)) { scan_mfma(F); if (PROBE & 2) { xcd_barrier(bar); scan_mfma(F); } } SEAM(10);
#endif
    if (IN(11)) { px5(F); if (PROBE & 1) { xcd_barrier(bar); px5(F); } } SEAM(11);
    if (IN(12)) {
        pg8::Gemm g{H, (const bf16*)(F.ws + WS_WOUT1), MX, D, D}; pg8::StaticOrder S; S.init(MX, D, F.G, (int)blockIdx.x, D);
        pg8::EpiBf16SS E{Y, D, SS + 2 * MT, nullptr, 1};
        pg8::gemm_phase<pg8::EpiBf16SS, pg8::StaticOrder, true, true>(F.lds + RING_OFF, g, S, E); } SEAM(12);
    if (IN(13)) { px3(F, 1, MX, 2); } SEAM(13);
    if (IN(14)) {
        pg8::Gemm g{H, (const bf16*)(F.ws + WS_W1B), MX, FF, D}; pg8::StaticOrder S; S.init(MX, FF, F.G, (int)blockIdx.x);
        pg8::EpiBf16<2> E{BIG, FF};
        pg8::gemm_phase<pg8::EpiBf16<2>, pg8::StaticOrder, true, true>(F.lds + RING_OFF, g, S, E);
        if (PROBE & 4) { xcd_barrier(bar); pg8::gemm_phase<pg8::EpiBf16<2>, pg8::StaticOrder, true, true>(F.lds + RING_OFF, g, S, E); } } SEAM(14);
    if (IN(15)) {
        pg8::Gemm g{BIG, (const bf16*)(F.ws + WS_W2B), MX, D, FF}; pg8::StaticOrder S; S.init(MX, D, F.G, (int)blockIdx.x, FF, 1);
        pg8::EpiBf16SS E{Y, D, SS + 3 * MT, nullptr, 1};
        pg8::gemm_phase<pg8::EpiBf16SS, pg8::StaticOrder, true, true>(F.lds + RING_OFF, g, S, E); } SEAM(15);
    if (IN(16)) { px7(F); }
#undef IN
#undef SEAM
}

extern "C" void kernel_launch(void* const* d_in, const int* in_sizes, int n_in, void* d_out, int out_size, void* d_ws, size_t ws_size, hipStream_t stream) {
    static int grid = 0;
    if (grid == 0) {
        if (n_in != 17 || in_sizes[0] != MX * D || out_size != MX * D || ws_size < WS_END) { fprintf(stderr, "kernel_launch: unexpected problem (n_in %d, in0 %d, out %d, ws %zu < %zu); nothing launched\n", n_in, n_in > 0 ? in_sizes[0] : -1, out_size, ws_size, (size_t)WS_END); grid = -1; return; }
        int dev = 0, cus = 0, per_cu = 0;
        if (hipGetDevice(&dev) != hipSuccess || hipDeviceGetAttribute(&cus, hipDeviceAttributeMultiprocessorCount, dev) != hipSuccess) { fprintf(stderr, "kernel_launch: device query failed\n"); grid = -1; return; }
        if (hipFuncSetAttribute((const void*)fwd_kernel, hipFuncAttributeMaxDynamicSharedMemorySize, LDS_BYTES) != hipSuccess) { fprintf(stderr, "kernel_launch: hipFuncSetAttribute failed\n"); grid = -1; return; }
        if (hipOccupancyMaxActiveBlocksPerMultiprocessor(&per_cu, (const void*)fwd_kernel, NWAVES * 64, LDS_BYTES) != hipSuccess || per_cu < 1) { fprintf(stderr, "kernel_launch: occupancy query says %d blocks per CU\n", per_cu); per_cu = 1; }
        (void)hipGetLastError();
        grid = cus;
    }
    if (grid < 0) return;
    if (hipMemsetAsync((char*)d_ws + WS_CTL, 0, CTL_ZERO_BYTES, stream) != hipSuccess) { fprintf(stderr, "kernel_launch: memset failed\n"); return; }
    Args a{};
    for (int i = 0; i < 17; ++i) a.in[i] = (const float*)d_in[i];
    a.out = (float*)d_out; a.ws = (unsigned char*)d_ws;
    for (int li = 0; li < N_LAUNCHES; ++li) {
        a.ph_lo = (N_LAUNCHES == 1) ? 0 : li; a.ph_hi = (N_LAUNCHES == 1) ? N_PHASES : li + 1; a.li = li;
        hipLaunchKernelGGL(fwd_kernel, dim3(grid), dim3(NWAVES * 64), LDS_BYTES, stream, a);
        const hipError_t le = hipPeekAtLastError();
        if (le != hipSuccess) { fprintf(stderr, "kernel_launch: launch %d failed: %s\n", li, hipGetErrorName(le)); break; }
    }
}
```
